# Optimizing an MI355X kernel written in HIP

```python
import jax, jax.numpy as jnp
from jax import lax
import numpy as np


D_MODEL = 1024
BATCH = 2
SEQ = 8192
DEPTH = 1

GRID_W = 64
CTX_LEN = 256
CONV_W = 1024
RET_HEADS = 4
RET_DK = 256
RET_DV = 512
RET_QK = RET_HEADS * RET_DK
RET_V = RET_HEADS * RET_DV
RET_CHUNK = 128
ROPE_PAIRS = RET_DK // 4
ROPE_BASE = 10000.0
D_FF = 2816
N_MOD = 6
EPS = 1e-6

OFF_CX = 0
OFF_CB = OFF_CX + CONV_W
OFF_CC = OFF_CB + CONV_W
OFF_Q = OFF_CC + CONV_W
OFF_K = OFF_Q + RET_QK
OFF_V = OFF_K + RET_QK
OFF_G = OFF_V + RET_V
OFF_GA = OFF_G + RET_V
OFF_GB = OFF_GA + D_MODEL
IN_COLS = OFF_GB + D_MODEL

kernel_name = 'hybrid_conv_retention_diffusion_block'


def rms_norm(x, gain):
    xf = x.astype(jnp.float32)
    y = xf * lax.rsqrt(jnp.mean(xf * xf, axis=-1, keepdims=True) + EPS)
    return y.astype(x.dtype) * gain


def dwconv3(x, w, b, axis):
    n = x.shape[axis]
    pad = [(0, 0)] * x.ndim
    pad[axis] = (1, 1)
    xp = jnp.pad(x, pad)
    return (w[0] * lax.slice_in_dim(xp, 0, n, axis=axis)
            + w[1] * lax.slice_in_dim(xp, 1, n + 1, axis=axis)
            + w[2] * lax.slice_in_dim(xp, 2, n + 2, axis=axis) + b)


def grid_conv(x, w, b, axis):
    bsz, n, ch = x.shape
    rows = n // GRID_W
    xg = x.reshape(bsz, rows, GRID_W, ch)
    return dwconv3(xg, w, b, axis).reshape(bsz, n, ch)


def conv_along_rows(x, w, b):
    return grid_conv(x, w, b, 2)


def conv_along_cols(x, w, b):
    return grid_conv(x, w, b, 1)


def conv_along_seq(x, w, b):
    return dwconv3(x, w, b, 1)


def rotary_tables(n):
    t = jnp.arange(n)
    row = (t // GRID_W).astype(jnp.float32)
    col = (t % GRID_W).astype(jnp.float32)
    inv = ROPE_BASE ** (-jnp.arange(ROPE_PAIRS, dtype=jnp.float32) / ROPE_PAIRS)
    ang = jnp.concatenate([row[:, None] * inv, col[:, None] * inv], axis=-1)
    return jnp.cos(ang), jnp.sin(ang)


def apply_rotary(t, cos, sin):
    half = RET_DK // 2
    t1, t2 = t[..., :half], t[..., half:]
    return jnp.concatenate([t1 * cos - t2 * sin, t2 * cos + t1 * sin], axis=-1)


def to_heads(t, dh):
    bsz, n, _ = t.shape
    return t.reshape(bsz, n, RET_HEADS, dh).transpose(0, 2, 1, 3).astype(jnp.float32)


def flip_seq(t):
    return jnp.flip(t, axis=2)


def retention_scan(q, k, v, log_gamma, s0, strict):
    bsz, nh, n, dk = q.shape
    nc = n // RET_CHUNK
    idx = jnp.arange(RET_CHUNK, dtype=jnp.float32)
    diff = idx[:, None] - idx[None, :]
    mask = diff > 0 if strict else diff >= 0
    dmat = jnp.where(mask, jnp.exp(jnp.where(mask, diff, 0.0)[None] * log_gamma[:, None, None]), 0.0)
    xi = jnp.exp((idx + 1.0)[None, :] * log_gamma[:, None])
    zeta = jnp.exp((RET_CHUNK - 1.0 - idx)[None, :] * log_gamma[:, None])
    chunk_decay = jnp.exp(RET_CHUNK * log_gamma)

    def to_chunks(t):
        return jnp.moveaxis(t.reshape(bsz, nh, nc, RET_CHUNK, t.shape[-1]), 2, 0)

    def step(s, qkv):
        qc, kc, vc = qkv
        scores = jnp.einsum('bhnd,bhmd->bhnm', qc, kc) * dmat
        o = (jnp.einsum('bhnm,bhmv->bhnv', scores, vc)
             + jnp.einsum('bhnd,bhdv->bhnv', qc * xi[..., None], s))
        s = chunk_decay[:, None, None] * s + jnp.einsum('bhmd,bhmv->bhdv', kc * zeta[..., None], vc)
        return s, o

    s_final, o = lax.scan(step, s0, (to_chunks(q), to_chunks(k), to_chunks(v)))
    o = jnp.moveaxis(o, 0, 2).reshape(bsz, nh, n, v.shape[-1])
    return o, s_final


def context_states(kc, vc, lg_fw, lg_bw):
    lc = kc.shape[2]
    m = jnp.arange(lc, dtype=jnp.float32)
    w_fw = jnp.exp((lc - 1.0 - m)[None, :] * lg_fw[:, None])
    w_bw = jnp.exp(m[None, :] * lg_bw[:, None])
    s_fw = jnp.einsum('bhmd,hm,bhmv->bhdv', kc, w_fw, vc)
    s_bw = jnp.einsum('bhmd,hm,bhmv->bhdv', kc, w_bw, vc)
    return s_fw, s_bw


def mixer_branches(p, q, k, v, s_fw, s_bw, lg_fw, lg_bw, conv_w, conv_b, w_conv_out, w_ret_out, w_o, conv_fn):
    y_conv = (p[..., OFF_CB:OFF_CC]
              * conv_fn(p[..., OFF_CC:OFF_Q] * p[..., OFF_CX:OFF_CB], conv_w, conv_b)) @ w_conv_out
    o_fw, _ = retention_scan(q, k, v, lg_fw, s_fw, False)
    o_bw, _ = retention_scan(flip_seq(q), flip_seq(k), flip_seq(v), lg_bw, s_bw, True)
    o = o_fw + flip_seq(o_bw)
    o = o * lax.rsqrt(jnp.mean(o * o, axis=-1, keepdims=True) + EPS)
    bsz, _, n, _ = o.shape
    o = o.transpose(0, 2, 1, 3).reshape(bsz, n, RET_V).astype(p.dtype)
    y_ret = (jax.nn.silu(p[..., OFF_G:OFF_GA]) * o) @ w_ret_out
    merged = (jax.nn.sigmoid(p[..., OFF_GA:OFF_GB]) * y_conv
              + jax.nn.sigmoid(p[..., OFF_GB:IN_COLS]) * y_ret)
    return merged @ w_o


def conv_ffn(h, w_up, conv_w, conv_b, w_down, conv_fn):
    u = conv_fn(h @ w_up, conv_w, conv_b)
    return (jax.nn.silu(u[..., :D_FF]) * u[..., D_FF:]) @ w_down


def setup_inputs(seed: int = 0) -> dict:
    key = jax.random.key(seed)
    ks = jax.random.split(key, 22)

    def nrm(k, shape, scale):
        return jax.random.normal(k, shape, jnp.float32) * scale

    L = DEPTH
    D = D_MODEL
    theta0 = jnp.log(2.0 ** (5.0 + jnp.arange(RET_HEADS, dtype=jnp.float32)) - 1.0)
    return {
        'x': nrm(ks[0], (BATCH, SEQ, D), 1.0),
        'c': nrm(ks[1], (BATCH, D), 1.0),
        'ctx': nrm(ks[2], (BATCH, CTX_LEN, D), 1.0),
        'c_ctx': nrm(ks[3], (D,), 1.0),
        'w_ada': nrm(ks[4], (L, D, N_MOD * D), D ** -0.5),
        'b_ada': nrm(ks[5], (L, N_MOD * D), 0.01),
        'norm_mix_pre': 1.0 + nrm(ks[6], (L, D), 0.02),
        'norm_mix_post': 1.0 + nrm(ks[7], (L, D), 0.02),
        'w_in': nrm(ks[8], (L, D, IN_COLS), D ** -0.5),
        'conv_w': nrm(ks[9], (L, 3, CONV_W), 3 ** -0.5),
        'conv_b': nrm(ks[10], (L, CONV_W), 0.01),
        'w_conv_out': nrm(ks[11], (L, CONV_W, D), CONV_W ** -0.5),
        'ret_decay_fw': theta0 + nrm(ks[12], (L, RET_HEADS), 0.05),
        'ret_decay_bw': theta0 + nrm(ks[13], (L, RET_HEADS), 0.05),
        'w_ret_out': nrm(ks[14], (L, RET_V, D), RET_V ** -0.5),
        'w_o': nrm(ks[15], (L, D, D), D ** -0.5),
        'norm_ffn_pre': 1.0 + nrm(ks[16], (L, D), 0.02),
        'norm_ffn_post': 1.0 + nrm(ks[17], (L, D), 0.02),
        'w_ffn_up': nrm(ks[18], (L, D, 2 * D_FF), D ** -0.5),
        'ffn_conv_w': nrm(ks[19], (L, 3, 2 * D_FF), 3 ** -0.5),
        'ffn_conv_b': nrm(ks[20], (L, 2 * D_FF), 0.01),
        'w_ffn_down': nrm(ks[21], (L, D_FF, D), D_FF ** -0.5),
    }


def reference(x, c, ctx, c_ctx, w_ada, b_ada, norm_mix_pre, norm_mix_post, w_in, conv_w, conv_b,
              w_conv_out, ret_decay_fw, ret_decay_bw, w_ret_out, w_o, norm_ffn_pre, norm_ffn_post,
              w_ffn_up, ffn_conv_w, ffn_conv_b, w_ffn_down):
    bsz, n, _ = x.shape
    rows = n // GRID_W
    cos, sin = rotary_tables(rows * GRID_W)
    xc = ctx
    for layer in range(DEPTH):
        update_ctx = layer + 1 < DEPTH
        mod = (jax.nn.silu(c) @ w_ada[layer] + b_ada[layer]).reshape(bsz, N_MOD, 1, D_MODEL)
        mod_c = (jax.nn.silu(c_ctx) @ w_ada[layer] + b_ada[layer]).reshape(N_MOD, D_MODEL)
        lg_fw = jax.nn.log_sigmoid(ret_decay_fw[layer].astype(jnp.float32))
        lg_bw = jax.nn.log_sigmoid(ret_decay_bw[layer].astype(jnp.float32))

        h = rms_norm(x, norm_mix_pre[layer]) * (1.0 + mod[:, 1]) + mod[:, 0]
        hc = rms_norm(xc, norm_mix_pre[layer]) * (1.0 + mod_c[1]) + mod_c[0]
        if update_ctx:
            pc = hc @ w_in[layer]
            pc_kv = pc[..., OFF_K:OFF_G]
        else:
            pc_kv = hc @ w_in[layer][:, OFF_K:OFF_G]
        kc = to_heads(pc_kv[..., :RET_QK], RET_DK) * RET_DK ** -0.5
        vc = to_heads(pc_kv[..., RET_QK:], RET_DV)
        s_fw, s_bw = context_states(kc, vc, lg_fw, lg_bw)

        p = h @ w_in[layer]
        q = apply_rotary(to_heads(p[..., OFF_Q:OFF_K], RET_DK), cos, sin)
        k = apply_rotary(to_heads(p[..., OFF_K:OFF_V], RET_DK), cos, sin) * RET_DK ** -0.5
        v = to_heads(p[..., OFF_V:OFF_G], RET_DV)
        y = mixer_branches(p, q, k, v, s_fw, s_bw, lg_fw, lg_bw, conv_w[layer], conv_b[layer],
                           w_conv_out[layer], w_ret_out[layer], w_o[layer], conv_along_rows)
        if update_ctx:
            zero_state = jnp.zeros_like(s_fw)
            qc = to_heads(pc[..., OFF_Q:OFF_K], RET_DK)
            yc = mixer_branches(pc, qc, kc, vc, zero_state, zero_state, lg_fw, lg_bw, conv_w[layer],
                                conv_b[layer], w_conv_out[layer], w_ret_out[layer], w_o[layer],
                                conv_along_seq)
            xc = xc + mod_c[2] * rms_norm(yc, norm_mix_post[layer])
        x = x + mod[:, 2] * rms_norm(y, norm_mix_post[layer])

        h = rms_norm(x, norm_ffn_pre[layer]) * (1.0 + mod[:, 4]) + mod[:, 3]
        f = conv_ffn(h, w_ffn_up[layer], ffn_conv_w[layer], ffn_conv_b[layer], w_ffn_down[layer],
                     conv_along_cols)
        x = x + mod[:, 5] * rms_norm(f, norm_ffn_post[layer])
        if update_ctx:
            hc = rms_norm(xc, norm_ffn_pre[layer]) * (1.0 + mod_c[4]) + mod_c[3]
            fc = conv_ffn(hc, w_ffn_up[layer], ffn_conv_w[layer], ffn_conv_b[layer],
                          w_ffn_down[layer], conv_along_seq)
            xc = xc + mod_c[5] * rms_norm(fc, norm_ffn_post[layer])
    return x
```

```cpp
#include <hip/hip_runtime.h>
#include <hip/hip_cooperative_groups.h>
#include <cstdio>
#include <cstdint>
namespace cg = cooperative_groups;

#ifndef N_LAUNCH_MODE
#define N_LAUNCH_MODE 0
#endif

#define LAS __attribute__((address_space(3)))
typedef unsigned short bf16_t;
typedef short bf16x8 __attribute__((ext_vector_type(8)));
typedef float f32x4 __attribute__((ext_vector_type(4)));
typedef unsigned u32x4 __attribute__((ext_vector_type(4)));
typedef unsigned u32x2 __attribute__((ext_vector_type(2)));

constexpr int D = 1024, NB = 2, SEQ = 8192, MTOK = NB * SEQ, CTXL = 256, MCTX = NB * CTXL, MALL = MTOK + MCTX;
constexpr int INC = 11264, DFF = 2816, NMOD = 6;
constexpr int S_CX = 0, S_CB = 1024, S_CC = 2048, S_Q = 3072, S_K = 4096, S_V = 5120, S_G = 7168, S_GA = 9216, S_GB = 10240;
constexpr int R_Q = 0, R_K = 1024, R_V = 2048, R_G = 4096, R_C = 6144, R_GB = 10240;
constexpr float EPS = 1e-6f;
constexpr size_t MiB = (size_t)1 << 20;
constexpr size_t OFF_WT_IN = 0, OFF_WT_CO = 22 * MiB, OFF_WT_RO = 24 * MiB, OFF_WT_O = 28 * MiB, OFF_WT_UP = 30 * MiB, OFF_WT_DN = 41 * MiB,
                 OFF_SMALL = 47 * MiB, OFF_SSAVE = 48 * MiB, OFF_H = 56 * MiB, OFF_Q = 89 * MiB, OFF_K = 121 * MiB, OFF_KT = 153 * MiB, OFF_VT = 186 * MiB,
                 OFF_O = 89 * MiB  , OFF_GB = 153 * MiB, OFF_ARET = 185 * MiB, OFF_Y = 89 * MiB, OFF_T = 56 * MiB  , OFF_MERGED = 153 * MiB  , OFF_AFFN = 89 * MiB, OFF_F = 185 * MiB, OFF_SSQP = 252 * MiB, WS_END = 256 * MiB;
constexpr size_t SM_MOD = 0, SM_COSA = 128 * 1024, SM_SINA = 160 * 1024, SM_COSB = 192 * 1024, SM_SINB = 224 * 1024, SM_DEC = 256 * 1024;
constexpr int LDS_ST_OFF = 139264, LDS_BYTES = LDS_ST_OFF + 16;
constexpr size_t SM_BAR = 512 * 1024, SM_SSQ = 640 * 1024;

struct Params { const float* in[22]; float* out; unsigned char* ws; };

typedef float f32x2_t __attribute__((ext_vector_type(2)));
typedef __bf16 bf16x2_t __attribute__((ext_vector_type(2)));
__device__ __forceinline__ unsigned cvt_pk_bf16(float lo, float hi) { const f32x2_t v = {lo, hi}; const bf16x2_t b = __builtin_convertvector(v, bf16x2_t); return __builtin_bit_cast(unsigned, b); }
__device__ __forceinline__ float bf_lo(unsigned w) { return __builtin_bit_cast(float, w << 16); }
__device__ __forceinline__ float bf_hi(unsigned w) { return __builtin_bit_cast(float, w & 0xffff0000u); }
__device__ __forceinline__ u32x2 pk4(f32x4 v) { u32x2 r; r.x = cvt_pk_bf16(v[0], v[1]); r.y = cvt_pk_bf16(v[2], v[3]); return r; }
__device__ __forceinline__ u32x4 pk8(f32x4 a, f32x4 b) { u32x4 r; r.x = cvt_pk_bf16(a[0], a[1]); r.y = cvt_pk_bf16(a[2], a[3]); r.z = cvt_pk_bf16(b[0], b[1]); r.w = cvt_pk_bf16(b[2], b[3]); return r; }
__device__ __forceinline__ f32x4 unpk4(u32x2 w) { return (f32x4){bf_lo(w.x), bf_hi(w.x), bf_lo(w.y), bf_hi(w.y)}; }
__device__ __forceinline__ float sigmoidf_(float x) { return __builtin_amdgcn_rcpf(1.0f + __builtin_amdgcn_exp2f(-1.4426950408889634f * x)); }
__device__ __forceinline__ float siluf_(float x) { return x * __builtin_amdgcn_rcpf(1.0f + __builtin_amdgcn_exp2f(-1.4426950408889634f * x)); }
__device__ __forceinline__ float wave_sum(float v) {
#pragma unroll
    for (int o = 1; o < 64; o <<= 1) v += __shfl_xor(v, o);
    return v;
}
template <int CTRL> __device__ __forceinline__ float dppmov(float oldv, float src) {
    return __builtin_bit_cast(float, __builtin_amdgcn_update_dpp(__builtin_bit_cast(int, oldv), __builtin_bit_cast(int, src), CTRL, 0xF, 0xF, false));
}
__device__ __forceinline__ float up_nb(float prev, float cur) { const float t = dppmov<0x121>(0.f, prev); return dppmov<0x111>(t, cur); }
__device__ __forceinline__ float dn_nb(float next, float cur) { const float t = dppmov<0x12F>(0.f, next); return dppmov<0x101>(t, cur); }


#define XB_TMO      128
#define XB_XCNT(j)  (256  + 64 * (j))
#define XB_XSUB(j)  (1280 + 64 * (j))
#define XB_XGEN(j)  (2304 + 64 * (j))
#define XB_TOP      3328
#define XB_TOPGEN   3392
#define XCD_BAR_WORDS 3456
#define XB_SPIN_CAP (1u << 22)
__device__ __forceinline__ unsigned xb_ld(unsigned* p)              { return __hip_atomic_load(p, __ATOMIC_RELAXED, __HIP_MEMORY_SCOPE_AGENT); }
__device__ __forceinline__ unsigned xb_add(unsigned* p, unsigned v) { return __hip_atomic_fetch_add(p, v, __ATOMIC_RELAXED, __HIP_MEMORY_SCOPE_AGENT); }
__device__ __forceinline__ unsigned xb_xcc_id() { return (unsigned)__builtin_amdgcn_s_getreg((3 << 11) | 20) & 0xFu; }
#define XB_SPIN(cond, bar) do { unsigned _sp = 0; while (cond) { __builtin_amdgcn_s_sleep(1); \
    if ((++_sp & 255u) == 0u) { if (xb_ld(&(bar)[XB_TMO])) break; if (_sp > XB_SPIN_CAP) { atomicAdd(&(bar)[XB_TMO], 1u); break; } } } } while (0)
struct XcdBarrier { unsigned* bar; unsigned x; volatile LAS unsigned* st; };
__device__ __forceinline__ XcdBarrier xcd_barrier_post(unsigned* bar, volatile LAS unsigned* st) {
    XcdBarrier b; b.bar = bar; b.x = xb_xcc_id(); b.st = st;
    if (threadIdx.x == 0) (void)xb_add(&bar[XB_XCNT(b.x)], 1u);
    return b;
}
__device__ __forceinline__ void xcd_barrier_complete(unsigned* bar, unsigned x, unsigned& nloc, unsigned& nx) {
    const unsigned G = gridDim.x * gridDim.y * gridDim.z;
    unsigned sum, cnt, mine, sp = 0u;
    for (;;) {
        sum = 0u; cnt = 0u; mine = 0u;
#pragma unroll
        for (unsigned j = 0; j < 16; ++j) { const unsigned c = xb_ld(&bar[XB_XCNT(j)]); sum += c; cnt += (c > 0u) ? 1u : 0u; mine = (j == x) ? c : mine; }
        if (sum == G) break;
        __builtin_amdgcn_s_sleep(1);
        if ((++sp & 255u) == 0u) { if (xb_ld(&bar[XB_TMO])) break; if (sp > XB_SPIN_CAP) { atomicAdd(&bar[XB_TMO], 1u); break; } }
    }
    nloc = mine > 0u ? mine : 1u; nx = cnt > 0u ? cnt : 1u;
}
__device__ __forceinline__ void xcd_barrier(const XcdBarrier& b) {
    asm volatile("s_waitcnt vmcnt(0)" ::: "memory");
    __syncthreads();
    if (threadIdx.x == 0) {
        unsigned* bar = b.bar;
        __builtin_amdgcn_s_waitcnt(0);
        unsigned nloc = b.st[0], nx = b.st[1];
        if (nloc == 0u) { xcd_barrier_complete(bar, b.x, nloc, nx); b.st[0] = nloc; b.st[1] = nx; }
        const unsigned old = xb_add(&bar[XB_XSUB(b.x)], 1u);
        const unsigned gen = old / nloc;
        if (old + 1u == (gen + 1u) * nloc) {
            __builtin_amdgcn_fence(__ATOMIC_RELEASE, "agent");
            asm volatile("s_waitcnt vmcnt(0)" ::: "memory");
            const unsigned og = xb_add(&bar[XB_TOP], 1u);
            const unsigned tg = og / nx;
            if (og + 1u == (tg + 1u) * nx) xb_add(&bar[XB_TOPGEN], 1u);
            else XB_SPIN(xb_ld(&bar[XB_TOPGEN]) == tg, bar);
            __builtin_amdgcn_fence(__ATOMIC_ACQUIRE, "agent");
            xb_add(&bar[XB_XGEN(b.x)], 1u);
            asm volatile("s_waitcnt vmcnt(0)" ::: "memory");
        } else {
            XB_SPIN(xb_ld(&bar[XB_XGEN(b.x)]) == gen, bar);
            __builtin_amdgcn_fence(__ATOMIC_ACQUIRE, "agent");
            asm volatile("s_waitcnt vmcnt(0)" ::: "memory");
        }
    }
    __syncthreads();
}

namespace pg8 {
constexpr int BM = 256, BK = 64, HALF = 128, HTB = HALF * BK * 2, STAGE_BYTES = 8 * HTB, NXCD = 8, WGM = 8;
__host__ __device__ __forceinline__ int lds_byte(int r, int c) { const int st = (r >> 4) * 2 + (c >> 5), rr = r & 15, cc = c & 31, ob = rr * 64 + cc * 2; return st * 1024 + (ob ^ (((ob >> 9) & 1) << 5)); }
__host__ __device__ __forceinline__ void stage_rc(int b, int& R, int& C) { const int st = b / 1024, sb = b % 1024, swz = sb ^ (((sb >> 9) & 1) << 5); R = (st >> 1) * 16 + swz / 64; C = (st & 1) * 32 + (swz % 64) / 2; }
__host__ __device__ __forceinline__ int perm32(int rho) { const int n = rho >> 4, i = rho & 15; return 8 * (i >> 2) + 4 * n + (i & 3); }
struct Unit { int pm, pn, kind; };
__device__ __forceinline__ void decode_tile(int wgid, int nM, int nN, int& pm, int& pn) {
    const int nwg = nM * nN;
    { const int q = nwg / NXCD, r = nwg % NXCD, xcd = wgid % NXCD, off = wgid / NXCD; wgid = (xcd < r ? xcd * (q + 1) : r * (q + 1) + (xcd - r) * q) + off; }
    const int nig = WGM * nN, gid = wgid / nig, fm = gid * WGM, gsz = (nM - fm) < WGM ? (nM - fm) : WGM;
    pm = fm + ((wgid % nig) % gsz); pn = (wgid % nig) / gsz;
}
struct Sched1 {
    int nM, nN, G, c; const char* A; const char* B; size_t tstep;
    __device__ __forceinline__ bool next(int i, Unit& u) const { const long L = (long)i * G + c; if (L >= (long)nM * nN) return false; decode_tile((int)L, nM, nN, u.pm, u.pn); u.kind = 0; return true; }
    __device__ __forceinline__ const char* baseA(const Unit& u) const { return A + (size_t)u.pm * tstep; }
    __device__ __forceinline__ const char* baseB(const Unit& u) const { return B + (size_t)u.pn * tstep; }
};

template <class Epi, class Sched>
__device__ __forceinline__ void gemm_phase(LAS unsigned char* lds, const int K, const Sched& S, const Epi& E) {
    const int tid = threadIdx.x, wid = __builtin_amdgcn_readfirstlane(tid >> 6), lane = tid & 63, wr = wid >> 2, wc = wid & 3, fr = lane & 15, fq = lane >> 4;
    const int nt = K / BK;
    unsigned voffA[2], voffB[2];
#pragma unroll
    for (int i = 0; i < 2; ++i) { int R, C; stage_rc(tid * 16 + i * 8192, R, C); const int Rb = Epi::PERM ? ((R & ~31) + perm32(R & 31)) : R; voffA[i] = (unsigned)(R * K + C) * 2u; voffB[i] = (unsigned)(Rb * K + C) * 2u; }
    const size_t kstep = (size_t)(BK * 2);
    const size_t hstep = (size_t)HALF * K * 2;
    const unsigned ldsw = (unsigned)wid * 1024u;
    const int aoff = lds_byte(wr * 64 + fr, fq * 8), boff = lds_byte(wc * 32 + fr, fq * 8);
#define PG8_SA(b, h) (((b) * 2 + (h)) * HTB)
#define PG8_SB(b, h) ((4 + (b) * 2 + (h)) * HTB)
#define PG8_STAGE(bufoff, gbase, voff) do { _Pragma("unroll") for (int _i = 0; _i < 2; ++_i) \
        __builtin_amdgcn_global_load_lds((const unsigned*)((const char*)(gbase) + (voff)[_i]), (LAS unsigned*)(lds + (bufoff) + ldsw + _i * 8192), 16, 0, 0); } while (0)
#define PG8_LDA(dst, b, h) do { _Pragma("unroll") for (int m = 0; m < 4; ++m) _Pragma("unroll") for (int k = 0; k < 2; ++k) dst[m][k] = *(const LAS bf16x8*)(lds + PG8_SA(b, h) + aoff + m * 2048 + k * 1024); } while (0)
#define PG8_LDB(dst, b, h) do { _Pragma("unroll") for (int n = 0; n < 2; ++n) _Pragma("unroll") for (int k = 0; k < 2; ++k) dst[n][k] = *(const LAS bf16x8*)(lds + PG8_SB(b, h) + boff + n * 2048 + k * 1024); } while (0)
#define PG8_MMA(ai, bj, At, Bt) do { __builtin_amdgcn_s_setprio(1); _Pragma("unroll") for (int m = 0; m < 4; ++m) _Pragma("unroll") for (int n = 0; n < 2; ++n) _Pragma("unroll") for (int k = 0; k < 2; ++k) \
        acc[ai][bj][m][n] = __builtin_amdgcn_mfma_f32_16x16x32_bf16(Bt[n][k], At[m][k], acc[ai][bj][m][n], 0, 0, 0); __builtin_amdgcn_s_setprio(0); } while (0)
#define PG8_WAIT_V(n) asm volatile("s_waitcnt vmcnt(" #n ")" ::: "memory")
#define PG8_WAIT_L(n) asm volatile("s_waitcnt lgkmcnt(" #n ")" ::: "memory")
#define PG8_BAR __builtin_amdgcn_s_barrier()
#define PG8_SCHED __builtin_amdgcn_sched_barrier(0)
    Unit cur, nxt; int ui = 0;
    if (!S.next(0, cur)) return;
    f32x4 acc[2][2][4][2];
#pragma unroll
    for (int a = 0; a < 2; ++a)
#pragma unroll
        for (int b = 0; b < 2; ++b)
#pragma unroll
            for (int m = 0; m < 4; ++m)
#pragma unroll
                for (int n = 0; n < 2; ++n) acc[a][b][m][n] = (f32x4){0.f, 0.f, 0.f, 0.f};
    bf16x8 At[4][2], B0[2][2], B1[2][2];
    const char* cA = S.baseA(cur); const char* cB = S.baseB(cur);
    PG8_STAGE(PG8_SB(0, 0), cB, voffB); PG8_STAGE(PG8_SB(0, 1), cB + hstep, voffB); PG8_STAGE(PG8_SA(0, 0), cA, voffA); PG8_STAGE(PG8_SA(0, 1), cA + hstep, voffA);
    if (wr == 1) PG8_BAR;
    PG8_WAIT_V(2); PG8_BAR;
    PG8_STAGE(PG8_SB(1, 0), cB + kstep, voffB); PG8_STAGE(PG8_SA(1, 0), cA + kstep, voffA); PG8_STAGE(PG8_SB(1, 1), cB + hstep + kstep, voffB);
    PG8_WAIT_V(6); PG8_BAR;
    for (;;) {
        const bool has_next = S.next(ui + 1, nxt);
        const char* nA = has_next ? S.baseA(nxt) : cA; const char* nB = has_next ? S.baseB(nxt) : cB;
        for (int t = 0; t < nt; t += 2) {
            const bool last = (t == nt - 2);
            const char* a1 = cA + (size_t)(t + 1) * kstep;
            const char* a2 = last ? nA : cA + (size_t)(t + 2) * kstep; const char* b2 = last ? nB : cB + (size_t)(t + 2) * kstep;
            const char* a3 = a2 + kstep; const char* b3 = b2 + kstep;
            PG8_LDB(B0, 0, 0); PG8_LDB(B1, 0, 1); PG8_SCHED; PG8_LDA(At, 0, 0); PG8_STAGE(PG8_SA(1, 1), a1 + hstep, voffA);
            PG8_WAIT_V(8); PG8_WAIT_L(0); PG8_BAR; PG8_MMA(0, 0, At, B0); PG8_MMA(0, 1, At, B1); PG8_BAR; PG8_SCHED;
            PG8_LDA(At, 0, 1); PG8_STAGE(PG8_SB(0, 0), b2, voffB); PG8_STAGE(PG8_SB(0, 1), b2 + hstep, voffB); PG8_STAGE(PG8_SA(0, 0), a2, voffA);
            PG8_WAIT_V(8); PG8_WAIT_L(0); PG8_BAR; PG8_MMA(1, 0, At, B0); PG8_MMA(1, 1, At, B1); PG8_BAR; PG8_SCHED;
            PG8_LDB(B0, 1, 0); PG8_LDB(B1, 1, 1); PG8_SCHED; PG8_LDA(At, 1, 0); PG8_STAGE(PG8_SA(0, 1), a2 + hstep, voffA);
            PG8_WAIT_V(8); PG8_WAIT_L(0); PG8_BAR; PG8_MMA(0, 0, At, B0); PG8_MMA(0, 1, At, B1); PG8_BAR; PG8_SCHED;
            PG8_LDA(At, 1, 1); PG8_STAGE(PG8_SB(1, 0), b3, voffB); PG8_STAGE(PG8_SB(1, 1), b3 + hstep, voffB); PG8_STAGE(PG8_SA(1, 0), a3, voffA);
            PG8_WAIT_V(8); PG8_WAIT_L(0); PG8_BAR; PG8_MMA(1, 0, At, B0); PG8_MMA(1, 1, At, B1); PG8_BAR; PG8_SCHED;
        }
        if (wr == 0) PG8_BAR;
        E(acc, cur, wr, wc, fr, fq);
        if (!has_next) break;
#pragma unroll
        for (int a = 0; a < 2; ++a)
#pragma unroll
            for (int b = 0; b < 2; ++b)
#pragma unroll
                for (int m = 0; m < 4; ++m)
#pragma unroll
                    for (int n = 0; n < 2; ++n) acc[a][b][m][n] = (f32x4){0.f, 0.f, 0.f, 0.f};
        cur = nxt; cA = nA; cB = nB; ++ui;
        if (wr == 1) PG8_BAR;
    }
    PG8_WAIT_V(0);
    PG8_BAR;
#undef PG8_SA
#undef PG8_SB
#undef PG8_STAGE
#undef PG8_LDA
#undef PG8_LDB
#undef PG8_MMA
#undef PG8_WAIT_V
#undef PG8_WAIT_L
#undef PG8_BAR
#undef PG8_SCHED
}
}
using pg8::Unit;
typedef f32x4 Acc[2][2][4][2];

__device__ __forceinline__ unsigned qf_idx(int tok, int h, int dkl) { const unsigned frag = ((unsigned)(tok >> 4) * 4 + h) * 8 + (dkl >> 5); return (frag * 64 + ((dkl >> 3) & 3) * 16 + (tok & 15)) * 8 + (dkl & 7); }
__device__ __forceinline__ unsigned ktf_idx(int r, int tau) { const int tl = tau & 127; const unsigned frag = (((unsigned)(tau >> 7) * 4 + (r >> 8)) * 16 + ((r & 255) >> 4)) * 4 + (tl >> 5); return (frag * 64 + ((tl >> 3) & 3) * 16 + (r & 15)) * 8 + (tl & 7); }
struct SchedP2 {
    int G, c; const char* H; const char* W; size_t tstep;
    __device__ __forceinline__ bool next(int i, Unit& u) const {
        const long L = (long)i * G + c; if (L >= 1280) return false;
        if (L < 512) { u.kind = 0; pg8::decode_tile((int)L, 64, 8, u.pm, u.pn); } else { u.kind = 1; pg8::decode_tile((int)L - 512, 12, 64, u.pm, u.pn); }
        return true;
    }
    __device__ __forceinline__ const char* baseA(const Unit& u) const { return u.kind == 0 ? H + (size_t)u.pm * tstep : W + (size_t)(R_K / 256 + u.pm) * tstep; }
    __device__ __forceinline__ const char* baseB(const Unit& u) const { return u.kind == 0 ? W + (size_t)u.pn * tstep : H + (size_t)u.pn * tstep; }
};
struct EpiP2 {
    static constexpr bool PERM = true;
    bf16_t *Q, *Kk, *KT, *VT; const float *cosA, *sinA, *cosB, *sinB;
    __device__ __forceinline__ void operator()(const Acc& acc, const Unit& u, int wr, int wc, int fr, int fq) const {
        if (u.kind == 0) {
            const int head = u.pn & 3; const bool isK = u.pn >= 4; const float sc = isK ? 0.0625f : 1.0f;
            bf16_t* qbase = Q + ((((unsigned)((u.pm * 16 + wr * 4) * 4 + head) * 8 + wc) * 64 + fq * 16 + fr) * 8);
#pragma unroll
            for (int ai = 0; ai < 2; ++ai)
#pragma unroll
                for (int m = 0; m < 4; ++m) {
                    const int tok = u.pm * 256 + ai * 128 + wr * 64 + m * 16 + fr;
                    const int pos = (wc < 2) ? ((tok & (SEQ - 1)) >> 6) : (tok & 63);
                    f32x4 o1[2], o2[2];
#pragma unroll
                    for (int n = 0; n < 2; ++n) {
                        const int i0 = wc * 32 + fq * 8 + n * 4;
                        const f32x4 cs = *(const f32x4*)(cosA + pos * 64 + (i0 & 63)), sn = *(const f32x4*)(sinA + pos * 64 + (i0 & 63));
                        const f32x4 t1 = acc[ai][0][m][n], t2 = acc[ai][1][m][n];
                        o1[n] = (t1 * cs - t2 * sn) * sc; o2[n] = (t2 * cs + t1 * sn) * sc;
                    }
                    if (isK) { bf16_t* rp = Kk + (size_t)tok * 1024 + head * 256 + wc * 32 + fq * 8; *(u32x4*)rp = pk8(o1[0], o1[1]); *(u32x4*)(rp + 128) = pk8(o2[0], o2[1]); }
                    else { bf16_t* rp = qbase + (ai * 8 + m) * 16384; *(u32x4*)rp = pk8(o1[0], o1[1]); *(u32x4*)(rp + 2048) = pk8(o2[0], o2[1]); }
                }
        } else if (u.pm < 4) {
            bf16_t* ktbase = KT + (((((unsigned)((u.pn * 2) * 4 + u.pm) * 16 + wr * 4) * 4 + wc) * 64 + fq * 16 + fr) * 8);
#pragma unroll
            for (int m = 0; m < 4; ++m) {
                const int d = wr * 64 + m * 16 + fr;
#pragma unroll
                for (int bj = 0; bj < 2; ++bj) {
                    f32x4 o1[2], o2[2];
#pragma unroll
                    for (int n = 0; n < 2; ++n) {
                        const int tau = u.pn * 256 + bj * 128 + wc * 32 + fq * 8 + n * 4;
                        f32x4 cs, sn;
                        if (wr == 0) { const int pos = (tau & (SEQ - 1)) >> 6; const float c1 = cosA[pos * 64 + d], s1 = sinA[pos * 64 + d]; cs = (f32x4){c1, c1, c1, c1}; sn = (f32x4){s1, s1, s1, s1}; }
                        else { const int pos = tau & 63; cs = *(const f32x4*)(cosB + (d & 63) * 128 + pos); sn = *(const f32x4*)(sinB + (d & 63) * 128 + pos); }
                        const f32x4 t1 = acc[0][bj][m][n], t2 = acc[1][bj][m][n];
                        o1[n] = (t1 * cs - t2 * sn) * 0.0625f; o2[n] = (t2 * cs + t1 * sn) * 0.0625f;
                    }
                    bf16_t* rp = ktbase + bj * 131072 + m * 2048; *(u32x4*)rp = pk8(o1[0], o1[1]); *(u32x4*)(rp + 16384) = pk8(o2[0], o2[1]);
                }
            }
        } else {
#pragma unroll
            for (int ai = 0; ai < 2; ++ai)
#pragma unroll
                for (int m = 0; m < 4; ++m) {
                    bf16_t* rp = VT + (size_t)((u.pm - 4) * 256 + ai * 128 + wr * 64 + m * 16 + fr) * MALL + u.pn * 256 + wc * 32 + fq * 8;
#pragma unroll
                    for (int bj = 0; bj < 2; ++bj) *(u32x4*)(rp + bj * 128) = pk8(acc[ai][bj][m][0], acc[ai][bj][m][1]);
                }
        }
    }
};

struct EpiP6 {
    static constexpr bool PERM = true;
    bf16_t *O, *ARET, *ACONV, *GA, *GB; const float *cw, *cb, *ssq;
    __device__ __forceinline__ void operator()(const Acc& acc, const Unit& u, int wr, int wc, int fr, int fq) const {
        if (u.pn < 8) {
#pragma unroll
            for (int ai = 0; ai < 2; ++ai)
#pragma unroll
                for (int m = 0; m < 4; ++m) {
                    const int tokr = u.pm * 256 + ai * 128 + wr * 64 + m * 16 + fr;
                    const size_t off = (size_t)tokr * 2048 + u.pn * 256 + wc * 32 + fq * 8;
                    const f32x4* sp = (const f32x4*)(ssq + ((size_t)tokr * 4 + (u.pn >> 1)) * 16);
                    const f32x4 s0 = __builtin_nontemporal_load(sp), s1 = __builtin_nontemporal_load(sp + 1), s2 = __builtin_nontemporal_load(sp + 2), s3 = __builtin_nontemporal_load(sp + 3);
                    const float ssum = (((s0[0] + s0[1]) + (s0[2] + s0[3])) + ((s1[0] + s1[1]) + (s1[2] + s1[3]))) + (((s2[0] + s2[1]) + (s2[2] + s2[3])) + ((s3[0] + s3[1]) + (s3[2] + s3[3])));
                    const float rstd = rsqrtf(ssum * (1.0f / 512.0f) + EPS);
#pragma unroll
                    for (int bj = 0; bj < 2; ++bj) {
                        const u32x4 ov = __builtin_nontemporal_load((const u32x4*)(O + ((((size_t)(u.pm * 2 + ai) * 4 + (u.pn >> 1)) * 16 + (u.pn & 1) * 8 + bj * 4 + wc) * 8 + wr * 4 + m) * 512 + (fq * 16 + fr) * 8));
                        const f32x4 o0 = unpk4((u32x2){ov.x, ov.y}), o1 = unpk4((u32x2){ov.z, ov.w}); const f32x4 g0 = acc[ai][bj][m][0], g1 = acc[ai][bj][m][1];
                        f32x4 r0, r1;
#pragma unroll
                        for (int j = 0; j < 4; ++j) { r0[j] = siluf_(g0[j]) * (o0[j] * rstd); r1[j] = siluf_(g1[j]) * (o1[j] * rstd); }
                        *(u32x4*)(ARET + off + bj * 128) = pk8(r0, r1);
                    }
                }
        } else if (u.pn < 24) {
            const int ch0 = (u.pn - 8) * 64 + wc * 16 + fq * 4;
            const f32x4 w0 = *(const f32x4*)(cw + ch0), w1 = *(const f32x4*)(cw + 1024 + ch0), w2 = *(const f32x4*)(cw + 2048 + ch0), bb = *(const f32x4*)(cb + ch0);
#pragma unroll
            for (int ai = 0; ai < 2; ++ai) {
                f32x4 uu[4];
#pragma unroll
                for (int m = 0; m < 4; ++m) uu[m] = acc[ai][0][m][0] * acc[ai][0][m][1];
#pragma unroll
                for (int m = 0; m < 4; ++m) {
                    f32x4 r, sg;
#pragma unroll
                    for (int j = 0; j < 4; ++j) {
                        const float up = up_nb(m > 0 ? uu[m - 1][j] : 0.f, uu[m][j]);
                        const float dn = dn_nb(m < 3 ? uu[m + 1][j] : 0.f, uu[m][j]);
                        r[j] = acc[ai][1][m][0][j] * (w0[j] * up + w1[j] * uu[m][j] + w2[j] * dn + bb[j]);
                        sg[j] = sigmoidf_(acc[ai][1][m][1][j]);
                    }
                    const size_t off = (size_t)(u.pm * 256 + ai * 128 + wr * 64 + m * 16 + fr) * 1024 + ch0;
                    *(u32x2*)(ACONV + off) = pk4(r); *(u32x2*)(GA + off) = pk4(sg);
                }
            }
        } else {
#pragma unroll
            for (int ai = 0; ai < 2; ++ai)
#pragma unroll
                for (int m = 0; m < 4; ++m) {
                    bf16_t* rp = GB + (size_t)(u.pm * 256 + ai * 128 + wr * 64 + m * 16 + fr) * 1024 + (u.pn - 24) * 256 + wc * 32 + fq * 8;
#pragma unroll
                    for (int bj = 0; bj < 2; ++bj) { const f32x4 g0 = acc[ai][bj][m][0], g1 = acc[ai][bj][m][1]; f32x4 r0, r1;
#pragma unroll
                        for (int j = 0; j < 4; ++j) { r0[j] = sigmoidf_(g0[j]); r1[j] = sigmoidf_(g1[j]); }
                        *(u32x4*)(rp + bj * 128) = pk8(r0, r1); }
                }
        }
    }
};
template <int MODE> struct EpiMix {
    static constexpr bool PERM = true;
    bf16_t* dst; const bf16_t* add; const bf16_t* mul;
    __device__ __forceinline__ void operator()(const Acc& acc, const Unit& u, int wr, int wc, int fr, int fq) const {
#pragma unroll
        for (int ai = 0; ai < 2; ++ai)
#pragma unroll
            for (int m = 0; m < 4; ++m) {
                const size_t off = (size_t)(u.pm * 256 + ai * 128 + wr * 64 + m * 16 + fr) * 1024 + u.pn * 256 + wc * 32 + fq * 8;
#pragma unroll
                for (int bj = 0; bj < 2; ++bj) {
                    const size_t o2 = off + bj * 128; f32x4 r0 = acc[ai][bj][m][0], r1 = acc[ai][bj][m][1];
                    if (MODE >= 1) { const u32x4 d = __builtin_nontemporal_load((const u32x4*)(mul + o2)); r0 = r0 * unpk4((u32x2){d.x, d.y}); r1 = r1 * unpk4((u32x2){d.z, d.w}); }
                    if (MODE == 2) { const u32x4 a = __builtin_nontemporal_load((const u32x4*)(add + o2)); r0 = r0 + unpk4((u32x2){a.x, a.y}); r1 = r1 + unpk4((u32x2){a.z, a.w}); }
                    *(u32x4*)(dst + o2) = pk8(r0, r1);
                }
            }
    }
};
struct EpiP11 {
    static constexpr bool PERM = true;
    bf16_t* AF; const float *cw, *cb;
    __device__ __forceinline__ void operator()(const Acc& acc, const Unit& u, int wr, int wc, int fr, int fq) const {
        u32x2 keep[8];
#pragma unroll
        for (int n = 0; n < 2; ++n) {
            const int ch0 = u.pn * 128 + wc * 32 + fq * 8 + n * 4;
            const f32x4 g0 = *(const f32x4*)(cw + ch0), g1 = *(const f32x4*)(cw + 2 * DFF + ch0), g2 = *(const f32x4*)(cw + 4 * DFF + ch0), gb = *(const f32x4*)(cb + ch0);
            const f32x4 v0 = *(const f32x4*)(cw + DFF + ch0), v1 = *(const f32x4*)(cw + 3 * DFF + ch0), v2 = *(const f32x4*)(cw + 5 * DFF + ch0), vb = *(const f32x4*)(cb + DFF + ch0);
#pragma unroll
            for (int s = 0; s < 8; ++s) {
                f32x4 r;
#pragma unroll
                for (int j = 0; j < 4; ++j) {
                    const float cg_ = acc[s >> 2][0][s & 3][n][j], cv_ = acc[s >> 2][1][s & 3][n][j];
                    const float ugp = up_nb(s > 0 ? acc[(s - 1) >> 2][0][(s - 1) & 3][n][j] : 0.f, cg_);
                    const float ugn = dn_nb(s < 7 ? acc[(s + 1) >> 2][0][(s + 1) & 3][n][j] : 0.f, cg_);
                    const float uvp = up_nb(s > 0 ? acc[(s - 1) >> 2][1][(s - 1) & 3][n][j] : 0.f, cv_);
                    const float uvn = dn_nb(s < 7 ? acc[(s + 1) >> 2][1][(s + 1) & 3][n][j] : 0.f, cv_);
                    const float ug = g0[j] * ugp + g1[j] * cg_ + g2[j] * ugn + gb[j];
                    const float uv = v0[j] * uvp + v1[j] * cv_ + v2[j] * uvn + vb[j];
                    r[j] = siluf_(ug) * uv;
                }
                if (n == 0) keep[s] = pk4(r);
                else { const u32x2 hi = pk4(r); u32x4 o; o.x = keep[s].x; o.y = keep[s].y; o.z = hi.x; o.w = hi.y;
                    *(u32x4*)(AF + (size_t)(u.pm * 256 + (s >> 2) * 128 + wr * 64 + (s & 3) * 16 + fr) * DFF + u.pn * 128 + wc * 32 + fq * 8) = o; }
            }
        }
    }
};
struct EpiP12 {
    static constexpr bool PERM = true;
    bf16_t* F;
    __device__ __forceinline__ void operator()(const Acc& acc, const Unit& u, int wr, int wc, int fr, int fq) const {
        const int b = u.pm >> 5, gc = (u.pm & 31) * 2 + wr;
#pragma unroll
        for (int ai = 0; ai < 2; ++ai)
#pragma unroll
            for (int m = 0; m < 4; ++m) {
                const int tok = b * SEQ + (ai * 64 + m * 16 + fr) * 64 + gc;
                bf16_t* rp = F + (size_t)tok * 1024 + u.pn * 256 + wc * 32 + fq * 8;
#pragma unroll
                for (int bj = 0; bj < 2; ++bj) *(u32x4*)(rp + bj * 128) = pk8(acc[ai][bj][m][0], acc[ai][bj][m][1]);
            }
    }
};

struct RowMapId { int off; __device__ __forceinline__ int operator()(int n) const { return off + n; } };
struct RowMapIn {
    __device__ __forceinline__ int operator()(int n) const {
        int s, ch;
        if (n < S_Q) { if (n < S_CB) { s = 0; ch = n; } else if (n < S_CC) { s = 2; ch = n - S_CB; } else { s = 1; ch = n - S_CC; } }
        else if (n < S_K) return R_Q + (n - S_Q);
        else if (n < S_V) return R_K + (n - S_K);
        else if (n < S_G) return R_V + (n - S_V);
        else if (n < S_GA) return R_G + (n - S_G);
        else if (n < S_GB) { s = 3; ch = n - S_GA; }
        else return R_GB + (n - S_GB);
        const int cl = ch & 63;
        return R_C + 256 * (ch >> 6) + 128 * (s >> 1) + 32 * (cl >> 4) + 8 * ((cl >> 2) & 3) + 4 * (s & 1) + (cl & 3);
    }
};
struct RowMapUp { __device__ __forceinline__ int operator()(int n) const { const int v = n >= DFF, ch = v ? n - DFF : n; return 256 * (ch >> 7) + 128 * v + (ch & 127); } };

template <class RowMap>
__device__ __forceinline__ void transpose_item(const float* W, int K, int N, bf16_t* WT, const RowMap rm, LAS float* scr, int item, int lane) {
    const int nblk = N / 32, kb = item / nblk, nb = item % nblk, k0 = 64 * kb, n0 = 32 * nb;
    float tv[32];
#pragma unroll
    for (int i = 0; i < 32; ++i) tv[i] = __builtin_nontemporal_load(W + (size_t)(k0 + 2 * i + (lane >> 5)) * N + n0 + (lane & 31));
#pragma unroll
    for (int i = 0; i < 32; ++i) scr[(2 * i + (lane >> 5)) * 33 + (lane & 31)] = tv[i];
    asm volatile("s_waitcnt lgkmcnt(0)" ::: "memory");
    const int c = lane & 7;
#pragma unroll
    for (int j = 0; j < 4; ++j) { const int n = (lane >> 3) + 8 * j; const LAS float* s = scr + (8 * c) * 33 + n;
        u32x4 o; o.x = cvt_pk_bf16(s[0 * 33], s[1 * 33]); o.y = cvt_pk_bf16(s[2 * 33], s[3 * 33]); o.z = cvt_pk_bf16(s[4 * 33], s[5 * 33]); o.w = cvt_pk_bf16(s[6 * 33], s[7 * 33]);
        *(u32x4*)(WT + (size_t)rm(n0 + n) * K + k0 + 8 * c) = o; }
    asm volatile("s_waitcnt lgkmcnt(0)" ::: "memory");
}

__device__ __forceinline__ void phase0(const Params& p, LAS unsigned char* lds, int blk, int G) {
    const int tid = threadIdx.x, lane = tid & 63, wave = tid >> 6;
    float* small = (float*)(p.ws + OFF_SMALL);
    for (int i = blk * 512 + tid; i < 8192; i += G * 512) {
        const int pos = i >> 6, f = i & 63; const float inv = powf(10000.0f, -(float)f / 64.0f), ang = (float)pos * inv; const float cs = cosf(ang), sn = sinf(ang);
        ((float*)(p.ws + OFF_SMALL + SM_COSA))[pos * 64 + f] = cs; ((float*)(p.ws + OFF_SMALL + SM_SINA))[pos * 64 + f] = sn;
        ((float*)(p.ws + OFF_SMALL + SM_COSB))[f * 128 + pos] = cs; ((float*)(p.ws + OFF_SMALL + SM_SINB))[f * 128 + pos] = sn;
    }
    if (blk == 0 && tid < 8) {
        const float th = (tid < 4) ? p.in[12][tid] : p.in[13][tid - 4];
        const float lg = -(th > 0.f ? log1pf(expf(-th)) : (-th + log1pf(expf(th))));
        ((float*)(p.ws + OFF_SMALL + SM_DEC))[tid] = lg * 1.4426950408889634f;
    }
    if (blk < 96) {
        LAS float* sv = (LAS float*)lds; LAS float* red = sv + 3 * 1024;
        for (int i = tid; i < 3 * 1024; i += 512) { const int v = i >> 10, k = i & 1023; const float cv = (v < 2) ? p.in[1][v * 1024 + k] : p.in[3][k]; sv[i] = siluf_(cv); }
        __syncthreads();
        for (int item = blk; item < 96; item += G) {
            const int kg = tid >> 6, col = item * 64 + (tid & 63); const float* wp = p.in[4] + (size_t)(kg * 128) * 6144 + col;
            float a0 = 0.f, a1 = 0.f, a2 = 0.f;
#pragma unroll 32
            for (int k = 0; k < 128; ++k) { const float w = __builtin_nontemporal_load(wp + (size_t)k * 6144); a0 += sv[kg * 128 + k] * w; a1 += sv[1024 + kg * 128 + k] * w; a2 += sv[2048 + kg * 128 + k] * w; }
            red[(kg * 64 + (tid & 63)) * 3 + 0] = a0; red[(kg * 64 + (tid & 63)) * 3 + 1] = a1; red[(kg * 64 + (tid & 63)) * 3 + 2] = a2;
            __syncthreads();
            if (tid < 192) { const int v = tid >> 6, cl = tid & 63; float s = p.in[5][item * 64 + cl];
#pragma unroll
                for (int g = 0; g < 8; ++g) s += red[(g * 64 + cl) * 3 + v];
                small[SM_MOD / 4 + v * 6144 + item * 64 + cl] = s; }
            __syncthreads();
        }
    }
    LAS float* scr = (LAS float*)(lds + wave * 8704);
    const int gw = blk * 8 + wave, NGW = G * 8;
    constexpr int I_IN = 16 * (INC / 32), I_CO = 16 * 32, I_RO = 32 * 32, I_O = 16 * 32, I_UP = 16 * (2 * DFF / 32), I_DN = (DFF / 64) * 32;
    constexpr int NITEMS = I_IN + I_CO + I_RO + I_O + I_UP + I_DN;
    for (int it = gw; it < NITEMS; it += NGW) {
        int r = it;
        if (r < I_IN) { transpose_item(p.in[8], 1024, INC, (bf16_t*)(p.ws + OFF_WT_IN), RowMapIn{}, scr, r, lane); continue; } r -= I_IN;
        if (r < I_CO) { transpose_item(p.in[11], 1024, 1024, (bf16_t*)(p.ws + OFF_WT_CO), RowMapId{0}, scr, r, lane); continue; } r -= I_CO;
        if (r < I_RO) { transpose_item(p.in[14], 2048, 1024, (bf16_t*)(p.ws + OFF_WT_RO), RowMapId{0}, scr, r, lane); continue; } r -= I_RO;
        if (r < I_O) { transpose_item(p.in[15], 1024, 1024, (bf16_t*)(p.ws + OFF_WT_O), RowMapId{0}, scr, r, lane); continue; } r -= I_O;
        if (r < I_UP) { transpose_item(p.in[18], 1024, 2 * DFF, (bf16_t*)(p.ws + OFF_WT_UP), RowMapUp{}, scr, r, lane); continue; } r -= I_UP;
        transpose_item(p.in[21], DFF, 1024, (bf16_t*)(p.ws + OFF_WT_DN), RowMapId{0}, scr, r, lane);
    }
}

__device__ __forceinline__ void phase1(const Params& p, int blk, int G) {
    const int lane = threadIdx.x & 63, gw = blk * 8 + (threadIdx.x >> 6), NGW = G * 8;
    const float* mod = (const float*)(p.ws + OFF_SMALL + SM_MOD); bf16_t* H = (bf16_t*)(p.ws + OFF_H);
    auto rowsrc = [&](int row) { return row < MTOK ? p.in[0] + (size_t)row * 1024 : p.in[2] + (size_t)(row - MTOK) * 1024; };
    f32x4 x[4], xn[4];
    if (gw < MALL) { const float* s = rowsrc(gw);
#pragma unroll
        for (int j = 0; j < 4; ++j) x[j] = __builtin_nontemporal_load((const f32x4*)(s + 4 * lane + 256 * j)); }
    for (int row = gw; row < MALL; row += NGW) {
        const int nrow = row + NGW;
        if (nrow < MALL) { const float* s = rowsrc(nrow);
#pragma unroll
            for (int j = 0; j < 4; ++j) xn[j] = __builtin_nontemporal_load((const f32x4*)(s + 4 * lane + 256 * j)); }
        const int v = row < MTOK ? (row >> 13) : 2; const float* sh = mod + v * 6144; const float* scl = sh + 1024;
        float ss = 0.f;
#pragma unroll
        for (int j = 0; j < 4; ++j) ss += (x[j][0] * x[j][0] + x[j][1] * x[j][1]) + (x[j][2] * x[j][2] + x[j][3] * x[j][3]);
        const float rs = rsqrtf(wave_sum(ss) * (1.0f / 1024.0f) + EPS);
#pragma unroll
        for (int j = 0; j < 4; ++j) { const int c = 4 * lane + 256 * j; const f32x4 g = *(const f32x4*)(p.in[6] + c), s1 = *(const f32x4*)(scl + c), s0 = *(const f32x4*)(sh + c);
            const f32x4 r = (x[j] * rs) * g * (s1 + 1.0f) + s0; *(u32x2*)(H + (size_t)row * 1024 + c) = pk4(r); }
#pragma unroll
        for (int j = 0; j < 4; ++j) x[j] = xn[j];
    }
}

#define LDS_BARRIER() do { asm volatile("s_waitcnt lgkmcnt(0)" ::: "memory"); __builtin_amdgcn_s_barrier(); asm volatile("" ::: "memory"); } while (0)
#define MFMA16(a, b, c) __builtin_amdgcn_mfma_f32_16x16x32_bf16((a), (b), (c), 0, 0, 0)
__device__ __forceinline__ void phase3(const Params& p, LAS unsigned char* lds, int blk, int G) {
    const int tid = threadIdx.x, lane = tid & 63, w = tid >> 6, fr = lane & 15, fq = lane >> 4;
    const bf16_t* Q = (const bf16_t*)p.out; const bf16_t* Kk = (const bf16_t*)p.out + (size_t)MTOK * 1024; const bf16_t* VT = (const bf16_t*)(p.ws + OFF_VT);
    bf16_t* O = (bf16_t*)(p.ws + OFF_O); const float* dec = (const float*)(p.ws + OFF_SMALL + SM_DEC);
    LAS bf16_t* Kl = (LAS bf16_t*)lds;
    LAS bf16_t* Vl = (LAS bf16_t*)(lds + 67584);
    LAS bf16_t* Pl = (LAS bf16_t*)(lds + w * 4352);
    {
        const bf16_t* Hc = (const bf16_t*)(p.ws + OFF_H) + (size_t)MTOK * 1024; const bf16_t* Wkv = (const bf16_t*)(p.ws + OFF_WT_IN) + (size_t)R_K * 1024;
        bf16_t* KTo = (bf16_t*)(p.ws + OFF_KT); bf16_t* VTo = (bf16_t*)(p.ws + OFF_VT);
        for (int t = blk * 8 + w; t < 96 * 16; t += G * 8) {
            const int row0 = (t >> 4) * 32, tok0 = (t & 15) * 32;
            f32x4 a[2][2];
#pragma unroll
            for (int i = 0; i < 2; ++i)
#pragma unroll
                for (int j = 0; j < 2; ++j) a[i][j] = (f32x4){0.f, 0.f, 0.f, 0.f};
            const bf16_t* hp = Hc + (size_t)(tok0 + fr) * 1024 + 8 * fq; const bf16_t* wp = Wkv + (size_t)(row0 + fr) * 1024 + 8 * fq;
#pragma unroll 8
            for (int ks = 0; ks < 32; ++ks) {
                const bf16x8 h0 = *(const bf16x8*)(hp + 32 * ks), h1 = *(const bf16x8*)(hp + 16 * 1024 + 32 * ks);
                const bf16x8 w0 = *(const bf16x8*)(wp + 32 * ks), w1 = *(const bf16x8*)(wp + 16 * 1024 + 32 * ks);
                a[0][0] = MFMA16(h0, w0, a[0][0]); a[0][1] = MFMA16(h1, w0, a[0][1]); a[1][0] = MFMA16(h0, w1, a[1][0]); a[1][1] = MFMA16(h1, w1, a[1][1]);
            }
#pragma unroll
            for (int i = 0; i < 2; ++i)
#pragma unroll
                for (int j = 0; j < 2; ++j) {
                    const int row = row0 + 16 * i + fr, tau = MTOK + tok0 + 16 * j + 4 * fq;
                    if (row < 1024) *(u32x2*)(KTo + ktf_idx(row, tau)) = pk4(a[i][j] * 0.0625f);
                    else *(u32x2*)(VTo + (size_t)(row - 1024) * MALL + tau) = pk4(a[i][j]);
                }
        }
    }
    for (int it = 0; it < (G == 256 ? 2 : (512 + G - 1) / G); ++it) {
        const int item = (G == 256) ? ((blk & 7) * 64 + (blk >> 3) + 32 * it) : (blk + it * G);
        if (item >= 512) break;
        const int c = item & 63, h = (item >> 6) & 3, b = item >> 8; const int t0 = b * SEQ + c * 128;
        const float lf = dec[h], lb = dec[4 + h];
        const float di = (float)(16 * w + fr - 4 * fq);
#pragma unroll
        for (int i = 0; i < 8; ++i) { const int idx = tid + 512 * i, row = idx >> 5, pc = idx & 31;
            *(LAS u32x4*)(Kl + row * 264 + pc * 8) = __builtin_nontemporal_load((const u32x4*)(Kk + (size_t)(t0 + row) * 1024 + h * 256 + pc * 8)); }
#pragma unroll
        for (int i = 0; i < 8; ++i) { const int idx = tid + 512 * i, row = idx >> 4, pc = idx & 15;
            *(LAS u32x4*)(Vl + row * 136 + pc * 8) = *(const u32x4*)(VT + (size_t)(h * 512 + (row & ~31) + 8 * ((row >> 2) & 3) + 4 * ((row >> 4) & 1) + (row & 3)) * MALL + t0 + pc * 8); }
        bf16x8 qf[8];
#pragma unroll
        for (int ks = 0; ks < 8; ++ks) qf[ks] = *(const bf16x8*)(Q + ((((size_t)((t0 >> 4) + w) * 4 + h) * 8 + ks) * 64 + lane) * 8);
        __syncthreads();
        u32x4 vnext[8];
#pragma unroll
        for (int i = 0; i < 8; ++i) { const int idx = tid + 512 * i, row = idx >> 4, pc = idx & 15;
            vnext[i] = *(const u32x4*)(VT + (size_t)(h * 512 + 256 + (row & ~31) + 8 * ((row >> 2) & 3) + 4 * ((row >> 4) & 1) + (row & 3)) * MALL + t0 + pc * 8); }
        u32x2 pr[8];
#pragma unroll
        for (int nt = 0; nt < 8; ++nt) {
            f32x4 a = (f32x4){0.f, 0.f, 0.f, 0.f};
#pragma unroll
            for (int ks = 0; ks < 8; ++ks) { const bf16x8 kf = *(const LAS bf16x8*)(Kl + (16 * nt + fr) * 264 + 32 * ks + 8 * fq); a = MFMA16(kf, qf[ks], a); }
            f32x4 r;
#pragma unroll
            for (int e = 0; e < 4; ++e) { const float dd = di - (float)(16 * nt + e); const float dm = __builtin_amdgcn_exp2f(dd >= 0.f ? lf * dd : -lb * dd); r[e] = a[e] * dm; }
            pr[nt] = pk4(r);
        }
        LDS_BARRIER();
#pragma unroll
        for (int nt = 0; nt < 8; ++nt) *(LAS u32x2*)(Pl + fr * 136 + 16 * nt + 4 * fq) = pr[nt];
        asm volatile("s_waitcnt lgkmcnt(0)" ::: "memory");
        bf16x8 pf[4];
#pragma unroll
        for (int ks = 0; ks < 4; ++ks) pf[ks] = *(const LAS bf16x8*)(Pl + fr * 136 + 32 * ks + 8 * fq);
#pragma unroll 1
        for (int half = 0; half < 2; ++half) {
            if (half == 1) {
                LDS_BARRIER();
#pragma unroll
                for (int i = 0; i < 8; ++i) { const int idx = tid + 512 * i, row = idx >> 4, pc = idx & 15; *(LAS u32x4*)(Vl + row * 136 + pc * 8) = vnext[i]; }
                LDS_BARRIER();
            }
            f32x4 oa[16];
#pragma unroll
            for (int nt = 0; nt < 16; ++nt) oa[nt] = (f32x4){0.f, 0.f, 0.f, 0.f};
#pragma unroll
            for (int ks = 0; ks < 4; ++ks)
#pragma unroll
                for (int nt = 0; nt < 16; ++nt) { const bf16x8 vf = *(const LAS bf16x8*)(Vl + (16 * nt + fr) * 136 + 32 * ks + 8 * fq); oa[nt] = MFMA16(vf, pf[ks], oa[nt]); }
            bf16_t* rp = O + (((((size_t)(t0 >> 7) * 4 + h) * 16 + half * 8) * 8 + w) * 512) + lane * 8;
#pragma unroll
            for (int g = 0; g < 8; ++g) *(u32x4*)(rp + (size_t)g * 8 * 512) = pk8(oa[2 * g], oa[2 * g + 1]);
        }
        __syncthreads();
    }
}

__device__ __forceinline__ int p4_col0(int s, int b, int dir) { return s < 2 ? MTOK + b * CTXL + (dir == 0 ? s : 1 - s) * 128 : b * SEQ + (dir == 0 ? s - 2 : 65 - s) * 128; }
__device__ __forceinline__ void phase4(const Params& p, LAS unsigned char* lds, int blk, int G, int s_lo, int s_hi) {
    const int tid = threadIdx.x, lane = tid & 63, w = tid >> 6, fr = lane & 15, fq = lane >> 4;
    const bf16_t* Q = (const bf16_t*)p.out; const bf16_t* KT = (const bf16_t*)(p.ws + OFF_KT); const bf16_t* VT = (const bf16_t*)(p.ws + OFF_VT);
    bf16_t* O = (bf16_t*)(p.ws + OFF_O); const float* dec = (const float*)(p.ws + OFF_SMALL + SM_DEC); float* ssave = (float*)(p.ws + OFF_SSAVE);
    float* ssq = (float*)(p.ws + OFF_SSQP);
    LAS bf16_t* Sb = (LAS bf16_t*)lds;
    LAS bf16_t* Vz = (LAS bf16_t*)(lds + 33792);
    for (int item = blk; item < 256; item += G) {
        const int xcd = item & 7, y = item >> 3, chain = xcd * 2 + (y & 1), slice = y >> 1;
        const int dir = chain & 1, h = (chain >> 1) & 3, b = chain >> 3;
        const float lg = dec[dir * 4 + h];
        const float dec128 = exp2f(lg * 128.0f);
        const int irow = 16 * w + fr; const float xi = exp2f(lg * (float)(dir == 0 ? irow + 1 : 128 - irow));
        const int vrow = tid >> 4, vpc = tid & 15;
        float zv[8];
#pragma unroll
        for (int e = 0; e < 8; ++e) { const int j = 8 * vpc + e; zv[e] = exp2f(lg * (float)(dir == 0 ? 127 - j : j)); }
        const bf16_t* vsrc = VT + (size_t)(h * 512 + slice * 32 + 8 * ((vrow >> 2) & 3) + 4 * (vrow >> 4) + (vrow & 3)) * MALL + 8 * vpc;
        const bf16_t* ksrc = KT + (size_t)lane * 8;
        const bf16_t* qsrc = Q + (size_t)lane * 8;
        bf16_t* osrc = O + (size_t)lane * 8;
#define P4_OT(c) (((((size_t)((c) >> 7) * 4 + h) * 16 + slice) * 8 + w) * 512)
        f32x4 Sa[2][2];
        if (s_lo == 0) {
#pragma unroll
            for (int mt = 0; mt < 2; ++mt)
#pragma unroll
                for (int nt = 0; nt < 2; ++nt) Sa[mt][nt] = (f32x4){0.f, 0.f, 0.f, 0.f};
        } else {
#pragma unroll
            for (int mt = 0; mt < 2; ++mt)
#pragma unroll
                for (int nt = 0; nt < 2; ++nt) Sa[mt][nt] = *(const f32x4*)(ssave + ((size_t)(item * 512 + tid) * 4 + mt * 2 + nt) * 4);
        }
        bf16x8 qc[8], kc[2][4]; u32x4 oold; u32x4 vraw;
        {
            const int c0 = p4_col0(s_lo, b, dir);
            const u32x4 v0 = __builtin_nontemporal_load((const u32x4*)(vsrc + c0));
#pragma unroll
            for (int mt = 0; mt < 2; ++mt)
#pragma unroll
                for (int ks = 0; ks < 4; ++ks) kc[mt][ks] = *(const bf16x8*)(ksrc + (((((size_t)(c0 >> 7) * 4 + h) * 16 + (2 * w + mt)) * 4 + ks) * 512));
            if (s_lo >= 2) {
#pragma unroll
                for (int ks = 0; ks < 8; ++ks) qc[ks] = *(const bf16x8*)(qsrc + ((((size_t)((c0 >> 4) + w) * 4 + h) * 8 + ks) * 512));
                oold = *(const u32x4*)(osrc + P4_OT(c0));
            } else {
#pragma unroll
                for (int ks = 0; ks < 8; ++ks) qc[ks] = (bf16x8){0, 0, 0, 0, 0, 0, 0, 0};
                oold = (u32x4){0u, 0u, 0u, 0u};
            }
            vraw = (s_lo + 1 < s_hi) ? __builtin_nontemporal_load((const u32x4*)(vsrc + p4_col0(s_lo + 1, b, dir))) : v0;
            LDS_BARRIER();
            const int buf = s_lo & 1;
#pragma unroll
            for (int mt = 0; mt < 2; ++mt)
#pragma unroll
                for (int nt = 0; nt < 2; ++nt) *(LAS u32x2*)(Sb + buf * 8448 + (16 * nt + fr) * 264 + 32 * w + 16 * mt + 4 * fq) = pk4(Sa[mt][nt]);
            u32x4 vs; vs.x = cvt_pk_bf16(bf_lo(v0.x) * zv[0], bf_hi(v0.x) * zv[1]); vs.y = cvt_pk_bf16(bf_lo(v0.y) * zv[2], bf_hi(v0.y) * zv[3]);
            vs.z = cvt_pk_bf16(bf_lo(v0.z) * zv[4], bf_hi(v0.z) * zv[5]); vs.w = cvt_pk_bf16(bf_lo(v0.w) * zv[6], bf_hi(v0.w) * zv[7]);
            *(LAS u32x4*)(Vz + buf * 4352 + vrow * 136 + 8 * vpc) = vs;
            LDS_BARRIER();
        }
        for (int s = s_lo; s < s_hi; ++s) {
            const int buf = s & 1; const bool lat = s >= 2, has1 = s + 1 < s_hi, lat1 = has1 && (s + 1 >= 2);
            const int c0 = p4_col0(s, b, dir), c1 = has1 ? p4_col0(s + 1, b, dir) : c0;
            f32x4 oa[2] = {(f32x4){0.f, 0.f, 0.f, 0.f}, (f32x4){0.f, 0.f, 0.f, 0.f}};
            if (lat) {
#pragma unroll
                for (int ks = 0; ks < 8; ++ks)
#pragma unroll
                    for (int nt = 0; nt < 2; ++nt) { const bf16x8 sf = *(const LAS bf16x8*)(Sb + buf * 8448 + (16 * nt + fr) * 264 + 32 * ks + 8 * fq); oa[nt] = MFMA16(sf, qc[ks], oa[nt]); }
            }
            bf16x8 qn[8];
            if (lat1) {
#pragma unroll
                for (int ks = 0; ks < 8; ++ks) qn[ks] = *(const bf16x8*)(qsrc + ((((size_t)((c1 >> 4) + w) * 4 + h) * 8 + ks) * 512));
            } else {
#pragma unroll
                for (int ks = 0; ks < 8; ++ks) qn[ks] = qc[ks];
            }
            f32x4 U[2][2];
#pragma unroll
            for (int mt = 0; mt < 2; ++mt)
#pragma unroll
                for (int nt = 0; nt < 2; ++nt) U[mt][nt] = (f32x4){0.f, 0.f, 0.f, 0.f};
#pragma unroll
            for (int ks = 0; ks < 4; ++ks) {
                bf16x8 vf[2];
#pragma unroll
                for (int nt = 0; nt < 2; ++nt) vf[nt] = *(const LAS bf16x8*)(Vz + buf * 4352 + (16 * nt + fr) * 136 + 32 * ks + 8 * fq);
#pragma unroll
                for (int mt = 0; mt < 2; ++mt)
#pragma unroll
                    for (int nt = 0; nt < 2; ++nt) U[mt][nt] = MFMA16(kc[mt][ks], vf[nt], U[mt][nt]);
            }
            bf16x8 kn[2][4];
#pragma unroll
            for (int mt = 0; mt < 2; ++mt)
#pragma unroll
                for (int ks = 0; ks < 4; ++ks) kn[mt][ks] = has1 ? *(const bf16x8*)(ksrc + (((((size_t)(c1 >> 7) * 4 + h) * 16 + (2 * w + mt)) * 4 + ks) * 512)) : kc[mt][ks];
#pragma unroll
            for (int mt = 0; mt < 2; ++mt)
#pragma unroll
                for (int nt = 0; nt < 2; ++nt) { Sa[mt][nt] = Sa[mt][nt] * dec128 + U[mt][nt];
                    *(LAS u32x2*)(Sb + (buf ^ 1) * 8448 + (16 * nt + fr) * 264 + 32 * w + 16 * mt + 4 * fq) = pk4(Sa[mt][nt]); }
            if (has1) {
                u32x4 vs; vs.x = cvt_pk_bf16(bf_lo(vraw.x) * zv[0], bf_hi(vraw.x) * zv[1]); vs.y = cvt_pk_bf16(bf_lo(vraw.y) * zv[2], bf_hi(vraw.y) * zv[3]);
                vs.z = cvt_pk_bf16(bf_lo(vraw.z) * zv[4], bf_hi(vraw.z) * zv[5]); vs.w = cvt_pk_bf16(bf_lo(vraw.w) * zv[6], bf_hi(vraw.w) * zv[7]);
                *(LAS u32x4*)(Vz + (buf ^ 1) * 4352 + vrow * 136 + 8 * vpc) = vs;
            }
            if (s + 2 < s_hi) vraw = __builtin_nontemporal_load((const u32x4*)(vsrc + p4_col0(s + 2, b, dir)));
            if (lat) {
                float sq = 0.f;
                const u32x2 o0 = pk4(unpk4((u32x2){oold.x, oold.y}) + oa[0] * xi), o1 = pk4(unpk4((u32x2){oold.z, oold.w}) + oa[1] * xi);
                { u32x4 ov; ov.x = o0.x; ov.y = o0.y; ov.z = o1.x; ov.w = o1.y; *(u32x4*)(osrc + P4_OT(c0)) = ov; }
                { const f32x4 f0 = unpk4(o0), f1 = unpk4(o1); sq = ((f0[0] * f0[0] + f0[1] * f0[1]) + (f0[2] * f0[2] + f0[3] * f0[3])) + ((f1[0] * f1[0] + f1[1] * f1[1]) + (f1[2] * f1[2] + f1[3] * f1[3])); }
                if (s_lo != 0) {
                    sq += __shfl_xor(sq, 16); sq += __shfl_xor(sq, 32);
                    if (fq == 0) ssq[((size_t)(c0 + irow) * 4 + h) * 16 + slice] = sq;
                }
            }
            if (lat1) oold = *(const u32x4*)(osrc + P4_OT(c1));
            LDS_BARRIER();
#pragma unroll
            for (int ks = 0; ks < 8; ++ks) qc[ks] = qn[ks];
#pragma unroll
            for (int mt = 0; mt < 2; ++mt)
#pragma unroll
                for (int ks = 0; ks < 4; ++ks) kc[mt][ks] = kn[mt][ks];
        }
#pragma unroll
        for (int mt = 0; mt < 2; ++mt)
#pragma unroll
            for (int nt = 0; nt < 2; ++nt) *(f32x4*)(ssave + ((size_t)(item * 512 + tid) * 4 + mt * 2 + nt) * 4) = Sa[mt][nt];
    }
}

__device__ __forceinline__ void phase5(const Params& p, int blk, int G) {
    const int lane = threadIdx.x & 63; bf16_t* O = (bf16_t*)p.out;
    for (int r = blk * 8 + (threadIdx.x >> 6); r < MTOK * 4; r += G * 8) {
        u32x4* pp = (u32x4*)(O + (size_t)r * 512 + lane * 8); const u32x4 v = *pp;
        float f[8] = {bf_lo(v.x), bf_hi(v.x), bf_lo(v.y), bf_hi(v.y), bf_lo(v.z), bf_hi(v.z), bf_lo(v.w), bf_hi(v.w)};
        float ss = 0.f;
#pragma unroll
        for (int e = 0; e < 8; ++e) ss += f[e] * f[e];
        const float rs = rsqrtf(wave_sum(ss) * (1.0f / 512.0f) + EPS);
        u32x4 o; o.x = cvt_pk_bf16(f[0] * rs, f[1] * rs); o.y = cvt_pk_bf16(f[2] * rs, f[3] * rs); o.z = cvt_pk_bf16(f[4] * rs, f[5] * rs); o.w = cvt_pk_bf16(f[6] * rs, f[7] * rs);
        *pp = o;
    }
}

__device__ __forceinline__ void phase10(const Params& p, int blk, int G) {
    const int lane = threadIdx.x & 63; const float* mod = (const float*)(p.ws + OFF_SMALL + SM_MOD);
    const bf16_t* Y = (const bf16_t*)(p.ws + OFF_Y); bf16_t* H2 = (bf16_t*)(p.ws + OFF_H);
    const int gw = blk * 8 + (threadIdx.x >> 6), NGW = G * 8;
    u32x2 yr[4], yrn[4]; f32x4 xv[4], xvn[4];
    if (gw < MTOK) {
#pragma unroll
        for (int j = 0; j < 4; ++j) { yr[j] = __builtin_nontemporal_load((const u32x2*)(Y + (size_t)gw * 1024 + 4 * lane + 256 * j)); xv[j] = __builtin_nontemporal_load((const f32x4*)(p.in[0] + (size_t)gw * 1024 + 4 * lane + 256 * j)); } }
    for (int row = gw; row < MTOK; row += NGW) {
        const int nrow = row + NGW;
        if (nrow < MTOK) {
#pragma unroll
            for (int j = 0; j < 4; ++j) { yrn[j] = __builtin_nontemporal_load((const u32x2*)(Y + (size_t)nrow * 1024 + 4 * lane + 256 * j)); xvn[j] = __builtin_nontemporal_load((const f32x4*)(p.in[0] + (size_t)nrow * 1024 + 4 * lane + 256 * j)); } }
        const int b = row >> 13; const float* md = mod + b * 6144;
        f32x4 y[4], x1[4]; float ss = 0.f;
#pragma unroll
        for (int j = 0; j < 4; ++j) { y[j] = unpk4(yr[j]); ss += (y[j][0] * y[j][0] + y[j][1] * y[j][1]) + (y[j][2] * y[j][2] + y[j][3] * y[j][3]); }
        const float rs = rsqrtf(wave_sum(ss) * (1.0f / 1024.0f) + EPS); float s2 = 0.f;
#pragma unroll
        for (int j = 0; j < 4; ++j) { const int c = 4 * lane + 256 * j; const f32x4 g = *(const f32x4*)(p.in[7] + c), gt = *(const f32x4*)(md + 2048 + c);
            x1[j] = xv[j] + gt * ((y[j] * rs) * g); *(f32x4*)(p.out + (size_t)row * 1024 + c) = x1[j];
            s2 += (x1[j][0] * x1[j][0] + x1[j][1] * x1[j][1]) + (x1[j][2] * x1[j][2] + x1[j][3] * x1[j][3]); }
        const float rs2 = rsqrtf(wave_sum(s2) * (1.0f / 1024.0f) + EPS);
        const int t = row & (SEQ - 1), gr = t >> 6, gc = t & 63; const int mu = 256 * (b * 32 + (gc >> 1)) + 128 * (gr >> 6) + 64 * (gc & 1) + (gr & 63);
#pragma unroll
        for (int j = 0; j < 4; ++j) { const int c = 4 * lane + 256 * j; const f32x4 g = *(const f32x4*)(p.in[16] + c), s1 = *(const f32x4*)(md + 4096 + c), s0 = *(const f32x4*)(md + 3072 + c);
            const f32x4 r = (x1[j] * rs2) * g * (s1 + 1.0f) + s0; *(u32x2*)(H2 + (size_t)mu * 1024 + c) = pk4(r); }
#pragma unroll
        for (int j = 0; j < 4; ++j) { yr[j] = yrn[j]; xv[j] = xvn[j]; }
    }
}
__device__ __forceinline__ void phase13(const Params& p, int blk, int G) {
    const int lane = threadIdx.x & 63; const float* mod = (const float*)(p.ws + OFF_SMALL + SM_MOD); const bf16_t* F = (const bf16_t*)(p.ws + OFF_F);
    const int gw = blk * 8 + (threadIdx.x >> 6), NGW = G * 8;
    u32x2 fr_[4], frn[4]; f32x4 ov[4], ovn[4];
    if (gw < MTOK) {
#pragma unroll
        for (int j = 0; j < 4; ++j) { fr_[j] = __builtin_nontemporal_load((const u32x2*)(F + (size_t)gw * 1024 + 4 * lane + 256 * j)); ov[j] = __builtin_nontemporal_load((const f32x4*)(p.out + (size_t)gw * 1024 + 4 * lane + 256 * j)); } }
    for (int row = gw; row < MTOK; row += NGW) {
        const int nrow = row + NGW;
        if (nrow < MTOK) {
#pragma unroll
            for (int j = 0; j < 4; ++j) { frn[j] = __builtin_nontemporal_load((const u32x2*)(F + (size_t)nrow * 1024 + 4 * lane + 256 * j)); ovn[j] = __builtin_nontemporal_load((const f32x4*)(p.out + (size_t)nrow * 1024 + 4 * lane + 256 * j)); } }
        const int b = row >> 13; const float* md = mod + b * 6144;
        f32x4 f[4]; float ss = 0.f;
#pragma unroll
        for (int j = 0; j < 4; ++j) { f[j] = unpk4(fr_[j]); ss += (f[j][0] * f[j][0] + f[j][1] * f[j][1]) + (f[j][2] * f[j][2] + f[j][3] * f[j][3]); }
        const float rs = rsqrtf(wave_sum(ss) * (1.0f / 1024.0f) + EPS);
#pragma unroll
        for (int j = 0; j < 4; ++j) { const int c = 4 * lane + 256 * j; const f32x4 g = *(const f32x4*)(p.in[17] + c), gt = *(const f32x4*)(md + 5120 + c);
            __builtin_nontemporal_store(ov[j] + gt * ((f[j] * rs) * g), (f32x4*)(p.out + (size_t)row * 1024 + c)); }
#pragma unroll
        for (int j = 0; j < 4; ++j) { fr_[j] = frn[j]; ov[j] = ovn[j]; }
    }
}

constexpr int NPHASE = 15;
template <bool COOP>
__global__ void __launch_bounds__(512, 2) k_main(Params p, int ph_lo, int ph_hi) {
    extern __shared__ __attribute__((aligned(16))) unsigned char shm[];
    LAS unsigned char* lds = (LAS unsigned char*)shm;
    const int blk = blockIdx.x, G = gridDim.x;
    unsigned char* ws = p.ws;
    XcdBarrier xb{};
    if constexpr (COOP) {
        volatile LAS unsigned* st = (volatile LAS unsigned*)(lds + LDS_ST_OFF);
        if (threadIdx.x == 0) { st[0] = 0u; st[1] = 0u; st[2] = 0u; st[3] = 0u; }
        __syncthreads();
        xb = xcd_barrier_post((unsigned*)(ws + OFF_SMALL + SM_BAR), st);
    }
    if constexpr (COOP) { if (ph_hi < 0) cg::this_grid().sync(); }
#define RUNPH(ph, SYNC, ...) if (ph_lo <= (ph) && (ph) < ph_hi) { if constexpr (COOP) { if ((ph) > ph_lo) { if (SYNC == 1) cg::this_grid().sync(); else if (SYNC == 2) xcd_barrier(xb); } } __VA_ARGS__ }
    RUNPH(0, 0, phase0(p, lds, blk, G);)
    RUNPH(1, 2, phase1(p, blk, G);)
    RUNPH(2, 2, { SchedP2 S{G, blk, (const char*)(ws + OFF_H), (const char*)(ws + OFF_WT_IN), (size_t)256 * 1024 * 2};
               EpiP2 E{(bf16_t*)p.out, (bf16_t*)p.out + (size_t)MTOK * 1024, (bf16_t*)(ws + OFF_KT), (bf16_t*)(ws + OFF_VT), (const float*)(ws + OFF_SMALL + SM_COSA), (const float*)(ws + OFF_SMALL + SM_SINA),
                       (const float*)(ws + OFF_SMALL + SM_COSB), (const float*)(ws + OFF_SMALL + SM_SINB)};
               pg8::gemm_phase(lds, 1024, S, E); })
    RUNPH(3, 2, phase3(p, lds, blk, G);)
    RUNPH(4, 2, phase4(p, lds, blk, G, 0, 34);)
    RUNPH(5, 2, phase4(p, lds, blk, G, 34, 66);)
    RUNPH(7, 2, { pg8::Sched1 S{64, 28, G, blk, (const char*)(ws + OFF_H), (const char*)(ws + OFF_WT_IN) + (size_t)R_G * 2048, (size_t)256 * 1024 * 2};
               EpiP6 E{(bf16_t*)(ws + OFF_O), (bf16_t*)(ws + OFF_ARET), (bf16_t*)p.out, (bf16_t*)p.out + (size_t)MTOK * 1024, (bf16_t*)(ws + OFF_GB), p.in[9], p.in[10], (const float*)(ws + OFF_SSQP)};
               pg8::gemm_phase(lds, 1024, S, E); })
    RUNPH(8, 2, { pg8::Sched1 S{64, 4, G, blk, (const char*)(ws + OFF_ARET), (const char*)(ws + OFF_WT_RO), (size_t)256 * 2048 * 2};
               EpiMix<1> E{(bf16_t*)(ws + OFF_T), nullptr, (const bf16_t*)(ws + OFF_GB)}; pg8::gemm_phase(lds, 2048, S, E); })
    if constexpr (COOP) { if (ph_lo <= 9 && 9 < ph_hi && 9 > ph_lo) {
        asm volatile("s_waitcnt vmcnt(0)" ::: "memory"); __syncthreads();
        if (threadIdx.x == 0) { __builtin_amdgcn_fence(__ATOMIC_ACQUIRE, "agent"); asm volatile("s_waitcnt vmcnt(0)" ::: "memory"); }
        __syncthreads(); } }
    RUNPH(9, 0, { pg8::Sched1 S{64, 4, G, blk, (const char*)p.out, (const char*)(ws + OFF_WT_CO), (size_t)256 * 1024 * 2};
               EpiMix<2> E{(bf16_t*)(ws + OFF_MERGED), (const bf16_t*)(ws + OFF_T), (const bf16_t*)p.out + (size_t)MTOK * 1024}; pg8::gemm_phase(lds, 1024, S, E); })
    RUNPH(10, 2, { pg8::Sched1 S{64, 4, G, blk, (const char*)(ws + OFF_MERGED), (const char*)(ws + OFF_WT_O), (size_t)256 * 1024 * 2};
                EpiMix<0> E{(bf16_t*)(ws + OFF_Y), nullptr, nullptr}; pg8::gemm_phase(lds, 1024, S, E); })
    RUNPH(11, 2, phase10(p, blk, G);)
    RUNPH(12, 2, { pg8::Sched1 S{64, 22, G, blk, (const char*)(ws + OFF_H), (const char*)(ws + OFF_WT_UP), (size_t)256 * 1024 * 2};
                EpiP11 E{(bf16_t*)(ws + OFF_AFFN), p.in[19], p.in[20]}; pg8::gemm_phase(lds, 1024, S, E); })
    RUNPH(13, 2, { pg8::Sched1 S{64, 4, G, blk, (const char*)(ws + OFF_AFFN), (const char*)(ws + OFF_WT_DN), (size_t)256 * DFF * 2};
                EpiP12 E{(bf16_t*)(ws + OFF_F)}; pg8::gemm_phase(lds, DFF, S, E); })
    RUNPH(14, 2, phase13(p, blk, G);)
#undef RUNPH
}

extern "C" void kernel_launch(void* const* d_in, const int* in_sizes, int n_in, void* d_out, int out_size, void* d_ws, size_t ws_size, hipStream_t stream) {
    static int grid = 0;
    if (grid == 0) {
        if (n_in != 22 || out_size != MTOK * D || ws_size < WS_END) { fprintf(stderr, "kernel_launch: unexpected shapes (n_in %d out %d ws %zu)\n", n_in, out_size, ws_size); grid = -1; return; }
        int dev = 0, cus = 0, per_cu = 0;
        (void)hipGetDevice(&dev); (void)hipDeviceGetAttribute(&cus, hipDeviceAttributeMultiprocessorCount, dev);
        (void)hipFuncSetAttribute((const void*)k_main<true>, hipFuncAttributeMaxDynamicSharedMemorySize, LDS_BYTES);
        (void)hipFuncSetAttribute((const void*)k_main<false>, hipFuncAttributeMaxDynamicSharedMemorySize, LDS_BYTES);
        if (hipOccupancyMaxActiveBlocksPerMultiprocessor(&per_cu, (const void*)k_main<true>, 512, LDS_BYTES) != hipSuccess || per_cu < 1) { fprintf(stderr, "kernel_launch: occupancy query says %d\n", per_cu); per_cu = 1; }
        (void)hipGetLastError();
        grid = cus * 1;
        if (grid > 256) grid = 256;
    }
    if (grid < 0) return;
    Params p{};
    for (int i = 0; i < 22; ++i) p.in[i] = (const float*)d_in[i];
    p.out = (float*)d_out; p.ws = (unsigned char*)d_ws;
#if N_LAUNCH_MODE == 0
    (void)hipMemsetAsync((unsigned char*)d_ws + OFF_SMALL + SM_BAR, 0, XCD_BAR_WORDS * 4, stream);
    int lo = 0, hi = NPHASE; void* args[] = {&p, &lo, &hi};
    hipError_t e = hipLaunchCooperativeKernel((const void*)k_main<true>, dim3(grid), dim3(512), args, LDS_BYTES, stream);
    if (e != hipSuccess) fprintf(stderr, "cooperative launch failed: %s (grid %d)\n", hipGetErrorString(e), grid);
#else
    for (int ph = 0; ph < NPHASE; ++ph) hipLaunchKernelGGL(k_main<false>, dim3(grid), dim3(512), LDS_BYTES, stream, p, ph, ph + 1);
#endif
}
```

```cpp
#include <hip/hip_runtime.h>
#include <hip/hip_cooperative_groups.h>
#include <cstdio>
#include <cstdint>
namespace cg = cooperative_groups;

#ifndef N_LAUNCH_MODE
#define N_LAUNCH_MODE 0
#endif

#define LAS __attribute__((address_space(3)))
typedef unsigned short bf16_t;
typedef short bf16x8 __attribute__((ext_vector_type(8)));
typedef float f32x4 __attribute__((ext_vector_type(4)));
typedef unsigned u32x4 __attribute__((ext_vector_type(4)));
typedef unsigned u32x2 __attribute__((ext_vector_type(2)));

constexpr int D = 1024, NB = 2, SEQ = 8192, MTOK = NB * SEQ, CTXL = 256, MCTX = NB * CTXL, MALL = MTOK + MCTX;
constexpr int INC = 11264, DFF = 2816, NMOD = 6;
constexpr int S_CX = 0, S_CB = 1024, S_CC = 2048, S_Q = 3072, S_K = 4096, S_V = 5120, S_G = 7168, S_GA = 9216, S_GB = 10240;
constexpr int R_Q = 0, R_K = 1024, R_V = 2048, R_G = 4096, R_C = 6144, R_GB = 10240;
constexpr float EPS = 1e-6f;
constexpr size_t MiB = (size_t)1 << 20;
constexpr size_t OFF_WT_IN = 0, OFF_WT_CO = 22 * MiB, OFF_WT_RO = 24 * MiB, OFF_WT_O = 28 * MiB, OFF_WT_UP = 30 * MiB, OFF_WT_DN = 41 * MiB,
                 OFF_SMALL = 47 * MiB, OFF_SSAVE = 48 * MiB, OFF_H = 56 * MiB, OFF_Q = 89 * MiB, OFF_K = 121 * MiB, OFF_KT = 153 * MiB, OFF_VT = 186 * MiB,
                 OFF_O = 89 * MiB  , OFF_GB = 153 * MiB, OFF_ARET = 185 * MiB, OFF_Y = 89 * MiB, OFF_T = 56 * MiB  , OFF_MERGED = 153 * MiB  , OFF_AFFN = 89 * MiB, OFF_F = 185 * MiB, OFF_SSQP = 252 * MiB, WS_END = 256 * MiB;
constexpr size_t SM_MOD = 0, SM_COSA = 128 * 1024, SM_SINA = 160 * 1024, SM_COSB = 192 * 1024, SM_SINB = 224 * 1024, SM_DEC = 256 * 1024;
constexpr int LDS_ST_OFF = 139264, LDS_BYTES = LDS_ST_OFF + 16;
constexpr size_t SM_BAR = 512 * 1024, SM_SSQ = 640 * 1024;

struct Params { const float* in[22]; float* out; unsigned char* ws; };

typedef float f32x2_t __attribute__((ext_vector_type(2)));
typedef __bf16 bf16x2_t __attribute__((ext_vector_type(2)));
__device__ __forceinline__ unsigned cvt_pk_bf16(float lo, float hi) { const f32x2_t v = {lo, hi}; const bf16x2_t b = __builtin_convertvector(v, bf16x2_t); return __builtin_bit_cast(unsigned, b); }
__device__ __forceinline__ float bf_lo(unsigned w) { return __builtin_bit_cast(float, w << 16); }
__device__ __forceinline__ float bf_hi(unsigned w) { return __builtin_bit_cast(float, w & 0xffff0000u); }
__device__ __forceinline__ u32x2 pk4(f32x4 v) { u32x2 r; r.x = cvt_pk_bf16(v[0], v[1]); r.y = cvt_pk_bf16(v[2], v[3]); return r; }
__device__ __forceinline__ u32x4 pk8(f32x4 a, f32x4 b) { u32x4 r; r.x = cvt_pk_bf16(a[0], a[1]); r.y = cvt_pk_bf16(a[2], a[3]); r.z = cvt_pk_bf16(b[0], b[1]); r.w = cvt_pk_bf16(b[2], b[3]); return r; }
__device__ __forceinline__ f32x4 unpk4(u32x2 w) { return (f32x4){bf_lo(w.x), bf_hi(w.x), bf_lo(w.y), bf_hi(w.y)}; }
__device__ __forceinline__ float sigmoidf_(float x) { return __builtin_amdgcn_rcpf(1.0f + __builtin_amdgcn_exp2f(-1.4426950408889634f * x)); }
__device__ __forceinline__ float siluf_(float x) { return x * __builtin_amdgcn_rcpf(1.0f + __builtin_amdgcn_exp2f(-1.4426950408889634f * x)); }
__device__ __forceinline__ float wave_sum(float v) {
#pragma unroll
    for (int o = 1; o < 64; o <<= 1) v += __shfl_xor(v, o);
    return v;
}
template <int CTRL> __device__ __forceinline__ float dppmov(float oldv, float src) {
    return __builtin_bit_cast(float, __builtin_amdgcn_update_dpp(__builtin_bit_cast(int, oldv), __builtin_bit_cast(int, src), CTRL, 0xF, 0xF, false));
}
__device__ __forceinline__ float up_nb(float prev, float cur) { const float t = dppmov<0x121>(0.f, prev); return dppmov<0x111>(t, cur); }
__device__ __forceinline__ float dn_nb(float next, float cur) { const float t = dppmov<0x12F>(0.f, next); return dppmov<0x101>(t, cur); }


#define XB_TMO      128
#define XB_XCNT(j)  (256  + 64 * (j))
#define XB_XSUB(j)  (1280 + 64 * (j))
#define XB_XGEN(j)  (2304 + 64 * (j))
#define XB_TOP      3328
#define XB_TOPGEN   3392
#define XCD_BAR_WORDS 3456
#define XB_SPIN_CAP (1u << 22)
__device__ __forceinline__ unsigned xb_ld(unsigned* p)              { return __hip_atomic_load(p, __ATOMIC_RELAXED, __HIP_MEMORY_SCOPE_AGENT); }
__device__ __forceinline__ unsigned xb_add(unsigned* p, unsigned v) { return __hip_atomic_fetch_add(p, v, __ATOMIC_RELAXED, __HIP_MEMORY_SCOPE_AGENT); }
__device__ __forceinline__ unsigned xb_xcc_id() { return (unsigned)__builtin_amdgcn_s_getreg((3 << 11) | 20) & 0xFu; }
#define XB_SPIN(cond, bar) do { unsigned _sp = 0; while (cond) { __builtin_amdgcn_s_sleep(1); \
    if ((++_sp & 255u) == 0u) { if (xb_ld(&(bar)[XB_TMO])) break; if (_sp > XB_SPIN_CAP) { atomicAdd(&(bar)[XB_TMO], 1u); break; } } } } while (0)
struct XcdBarrier { unsigned* bar; unsigned x; volatile LAS unsigned* st; };
__device__ __forceinline__ XcdBarrier xcd_barrier_post(unsigned* bar, volatile LAS unsigned* st) {
    XcdBarrier b; b.bar = bar; b.x = xb_xcc_id(); b.st = st;
    if (threadIdx.x == 0) (void)xb_add(&bar[XB_XCNT(b.x)], 1u);
    return b;
}
__device__ __forceinline__ void xcd_barrier_complete(unsigned* bar, unsigned x, unsigned& nloc, unsigned& nx) {
    const unsigned G = gridDim.x * gridDim.y * gridDim.z;
    unsigned sum, cnt, mine, sp = 0u;
    for (;;) {
        sum = 0u; cnt = 0u; mine = 0u;
#pragma unroll
        for (unsigned j = 0; j < 16; ++j) { const unsigned c = xb_ld(&bar[XB_XCNT(j)]); sum += c; cnt += (c > 0u) ? 1u : 0u; mine = (j == x) ? c : mine; }
        if (sum == G) break;
        __builtin_amdgcn_s_sleep(1);
        if ((++sp & 255u) == 0u) { if (xb_ld(&bar[XB_TMO])) break; if (sp > XB_SPIN_CAP) { atomicAdd(&bar[XB_TMO], 1u); break; } }
    }
    nloc = mine > 0u ? mine : 1u; nx = cnt > 0u ? cnt : 1u;
}
__device__ __forceinline__ void xcd_barrier(const XcdBarrier& b) {
    asm volatile("s_waitcnt vmcnt(0)" ::: "memory");
    __syncthreads();
    if (threadIdx.x == 0) {
        unsigned* bar = b.bar;
        __builtin_amdgcn_s_waitcnt(0);
        unsigned nloc = b.st[0], nx = b.st[1];
        if (nloc == 0u) { xcd_barrier_complete(bar, b.x, nloc, nx); b.st[0] = nloc; b.st[1] = nx; }
        const unsigned old = xb_add(&bar[XB_XSUB(b.x)], 1u);
        const unsigned gen = old / nloc;
        if (old + 1u == (gen + 1u) * nloc) {
            __builtin_amdgcn_fence(__ATOMIC_RELEASE, "agent");
            asm volatile("s_waitcnt vmcnt(0)" ::: "memory");
            const unsigned og = xb_add(&bar[XB_TOP], 1u);
            const unsigned tg = og / nx;
            if (og + 1u == (tg + 1u) * nx) xb_add(&bar[XB_TOPGEN], 1u);
            else XB_SPIN(xb_ld(&bar[XB_TOPGEN]) == tg, bar);
            __builtin_amdgcn_fence(__ATOMIC_ACQUIRE, "agent");
            xb_add(&bar[XB_XGEN(b.x)], 1u);
            asm volatile("s_waitcnt vmcnt(0)" ::: "memory");
        } else {
            XB_SPIN(xb_ld(&bar[XB_XGEN(b.x)]) == gen, bar);
            __builtin_amdgcn_fence(__ATOMIC_ACQUIRE, "agent");
            asm volatile("s_waitcnt vmcnt(0)" ::: "memory");
        }
    }
    __syncthreads();
}

namespace pg8 {
constexpr int BM = 256, BK = 64, HALF = 128, HTB = HALF * BK * 2, STAGE_BYTES = 8 * HTB, NXCD = 8, WGM = 8;
__host__ __device__ __forceinline__ int lds_byte(int r, int c) { const int st = (r >> 4) * 2 + (c >> 5), rr = r & 15, cc = c & 31, ob = rr * 64 + cc * 2; return st * 1024 + (ob ^ (((ob >> 9) & 1) << 5)); }
__host__ __device__ __forceinline__ void stage_rc(int b, int& R, int& C) { const int st = b / 1024, sb = b % 1024, swz = sb ^ (((sb >> 9) & 1) << 5); R = (st >> 1) * 16 + swz / 64; C = (st & 1) * 32 + (swz % 64) / 2; }
__host__ __device__ __forceinline__ int perm32(int rho) { const int n = rho >> 4, i = rho & 15; return 8 * (i >> 2) + 4 * n + (i & 3); }
struct Unit { int pm, pn, kind; };
__device__ __forceinline__ void decode_tile(int wgid, int nM, int nN, int& pm, int& pn) {
    const int nwg = nM * nN;
    { const int q = nwg / NXCD, r = nwg % NXCD, xcd = wgid % NXCD, off = wgid / NXCD; wgid = (xcd < r ? xcd * (q + 1) : r * (q + 1) + (xcd - r) * q) + off; }
    const int nig = WGM * nN, gid = wgid / nig, fm = gid * WGM, gsz = (nM - fm) < WGM ? (nM - fm) : WGM;
    pm = fm + ((wgid % nig) % gsz); pn = (wgid % nig) / gsz;
}
struct Sched1 {
    int nM, nN, G, c; const char* A; const char* B; size_t tstep;
    __device__ __forceinline__ bool next(int i, Unit& u) const { const long L = (long)i * G + c; if (L >= (long)nM * nN) return false; decode_tile((int)L, nM, nN, u.pm, u.pn); u.kind = 0; return true; }
    __device__ __forceinline__ const char* baseA(const Unit& u) const { return A + (size_t)u.pm * tstep; }
    __device__ __forceinline__ const char* baseB(const Unit& u) const { return B + (size_t)u.pn * tstep; }
};

template <class Epi, class Sched>
__device__ __forceinline__ void gemm_phase(LAS unsigned char* lds, const int K, const Sched& S, const Epi& E) {
    const int tid = threadIdx.x, wid = __builtin_amdgcn_readfirstlane(tid >> 6), lane = tid & 63, wr = wid >> 2, wc = wid & 3, fr = lane & 15, fq = lane >> 4;
    const int nt = K / BK;
    unsigned voffA[2], voffB[2];
#pragma unroll
    for (int i = 0; i < 2; ++i) { int R, C; stage_rc(tid * 16 + i * 8192, R, C); const int Rb = Epi::PERM ? ((R & ~31) + perm32(R & 31)) : R; voffA[i] = (unsigned)(R * K + C) * 2u; voffB[i] = (unsigned)(Rb * K + C) * 2u; }
    const size_t kstep = (size_t)(BK * 2);
    const size_t hstep = (size_t)HALF * K * 2;
    const unsigned ldsw = (unsigned)wid * 1024u;
    const int aoff = lds_byte(wr * 64 + fr, fq * 8), boff = lds_byte(wc * 32 + fr, fq * 8);
#define PG8_SA(b, h) (((b) * 2 + (h)) * HTB)
#define PG8_SB(b, h) ((4 + (b) * 2 + (h)) * HTB)
#define PG8_STAGE(bufoff, gbase, voff) do { _Pragma("unroll") for (int _i = 0; _i < 2; ++_i) \
        __builtin_amdgcn_global_load_lds((const unsigned*)((const char*)(gbase) + (voff)[_i]), (LAS unsigned*)(lds + (bufoff) + ldsw + _i * 8192), 16, 0, 0); } while (0)
#define PG8_LDA(dst, b, h) do { _Pragma("unroll") for (int m = 0; m < 4; ++m) _Pragma("unroll") for (int k = 0; k < 2; ++k) dst[m][k] = *(const LAS bf16x8*)(lds + PG8_SA(b, h) + aoff + m * 2048 + k * 1024); } while (0)
#define PG8_LDB(dst, b, h) do { _Pragma("unroll") for (int n = 0; n < 2; ++n) _Pragma("unroll") for (int k = 0; k < 2; ++k) dst[n][k] = *(const LAS bf16x8*)(lds + PG8_SB(b, h) + boff + n * 2048 + k * 1024); } while (0)
#define PG8_MMA(ai, bj, At, Bt) do { __builtin_amdgcn_s_setprio(1); _Pragma("unroll") for (int m = 0; m < 4; ++m) _Pragma("unroll") for (int n = 0; n < 2; ++n) _Pragma("unroll") for (int k = 0; k < 2; ++k) \
        acc[ai][bj][m][n] = __builtin_amdgcn_mfma_f32_16x16x32_bf16(Bt[n][k], At[m][k], acc[ai][bj][m][n], 0, 0, 0); __builtin_amdgcn_s_setprio(0); } while (0)
#define PG8_WAIT_V(n) asm volatile("s_waitcnt vmcnt(" #n ")" ::: "memory")
#define PG8_WAIT_L(n) asm volatile("s_waitcnt lgkmcnt(" #n ")" ::: "memory")
#define PG8_BAR __builtin_amdgcn_s_barrier()
#define PG8_SCHED __builtin_amdgcn_sched_barrier(0)
    Unit cur, nxt; int ui = 0;
    if (!S.next(0, cur)) return;
    f32x4 acc[2][2][4][2];
#pragma unroll
    for (int a = 0; a < 2; ++a)
#pragma unroll
        for (int b = 0; b < 2; ++b)
#pragma unroll
            for (int m = 0; m < 4; ++m)
#pragma unroll
                for (int n = 0; n < 2; ++n) acc[a][b][m][n] = (f32x4){0.f, 0.f, 0.f, 0.f};
    bf16x8 At[4][2], B0[2][2], B1[2][2];
    const char* cA = S.baseA(cur); const char* cB = S.baseB(cur);
    PG8_STAGE(PG8_SB(0, 0), cB, voffB); PG8_STAGE(PG8_SB(0, 1), cB + hstep, voffB); PG8_STAGE(PG8_SA(0, 0), cA, voffA); PG8_STAGE(PG8_SA(0, 1), cA + hstep, voffA);
    if (wr == 1) PG8_BAR;
    PG8_WAIT_V(2); PG8_BAR;
    PG8_STAGE(PG8_SB(1, 0), cB + kstep, voffB); PG8_STAGE(PG8_SA(1, 0), cA + kstep, voffA); PG8_STAGE(PG8_SB(1, 1), cB + hstep + kstep, voffB);
    PG8_WAIT_V(6); PG8_BAR;
    for (;;) {
        const bool has_next = S.next(ui + 1, nxt);
        const char* nA = has_next ? S.baseA(nxt) : cA; const char* nB = has_next ? S.baseB(nxt) : cB;
        for (int t = 0; t < nt; t += 2) {
            const bool last = (t == nt - 2);
            const char* a1 = cA + (size_t)(t + 1) * kstep;
            const char* a2 = last ? nA : cA + (size_t)(t + 2) * kstep; const char* b2 = last ? nB : cB + (size_t)(t + 2) * kstep;
            const char* a3 = a2 + kstep; const char* b3 = b2 + kstep;
            PG8_LDB(B0, 0, 0); PG8_LDB(B1, 0, 1); PG8_SCHED; PG8_LDA(At, 0, 0); PG8_STAGE(PG8_SA(1, 1), a1 + hstep, voffA);
            PG8_WAIT_V(8); PG8_WAIT_L(0); PG8_BAR; PG8_MMA(0, 0, At, B0); PG8_MMA(0, 1, At, B1); PG8_BAR; PG8_SCHED;
            PG8_LDA(At, 0, 1); PG8_STAGE(PG8_SB(0, 0), b2, voffB); PG8_STAGE(PG8_SB(0, 1), b2 + hstep, voffB); PG8_STAGE(PG8_SA(0, 0), a2, voffA);
            PG8_WAIT_V(8); PG8_WAIT_L(0); PG8_BAR; PG8_MMA(1, 0, At, B0); PG8_MMA(1, 1, At, B1); PG8_BAR; PG8_SCHED;
            PG8_LDB(B0, 1, 0); PG8_LDB(B1, 1, 1); PG8_SCHED; PG8_LDA(At, 1, 0); PG8_STAGE(PG8_SA(0, 1), a2 + hstep, voffA);
            PG8_WAIT_V(8); PG8_WAIT_L(0); PG8_BAR; PG8_MMA(0, 0, At, B0); PG8_MMA(0, 1, At, B1); PG8_BAR; PG8_SCHED;
            PG8_LDA(At, 1, 1); PG8_STAGE(PG8_SB(1, 0), b3, voffB); PG8_STAGE(PG8_SB(1, 1), b3 + hstep, voffB); PG8_STAGE(PG8_SA(1, 0), a3, voffA);
            PG8_WAIT_V(8); PG8_WAIT_L(0); PG8_BAR; PG8_MMA(1, 0, At, B0); PG8_MMA(1, 1, At, B1); PG8_BAR; PG8_SCHED;
        }
        if (wr == 0) PG8_BAR;
        E(acc, cur, wr, wc, fr, fq);
        if (!has_next) break;
#pragma unroll
        for (int a = 0; a < 2; ++a)
#pragma unroll
            for (int b = 0; b < 2; ++b)
#pragma unroll
                for (int m = 0; m < 4; ++m)
#pragma unroll
                    for (int n = 0; n < 2; ++n) acc[a][b][m][n] = (f32x4){0.f, 0.f, 0.f, 0.f};
        cur = nxt; cA = nA; cB = nB; ++ui;
        if (wr == 1) PG8_BAR;
    }
    PG8_WAIT_V(0);
    PG8_BAR;
#undef PG8_SA
#undef PG8_SB
#undef PG8_STAGE
#undef PG8_LDA
#undef PG8_LDB
#undef PG8_MMA
#undef PG8_WAIT_V
#undef PG8_WAIT_L
#undef PG8_BAR
#undef PG8_SCHED
}
}
using pg8::Unit;
typedef f32x4 Acc[2][2][4][2];

__device__ __forceinline__ unsigned qf_idx(int tok, int h, int dkl) { const unsigned frag = ((unsigned)(tok >> 4) * 4 + h) * 8 + (dkl >> 5); return (frag * 64 + ((dkl >> 3) & 3) * 16 + (tok & 15)) * 8 + (dkl & 7); }
__device__ __forceinline__ unsigned ktf_idx(int r, int tau) { const int tl = tau & 127; const unsigned frag = (((unsigned)(tau >> 7) * 4 + (r >> 8)) * 16 + ((r & 255) >> 4)) * 4 + (tl >> 5); return (frag * 64 + ((tl >> 3) & 3) * 16 + (r & 15)) * 8 + (tl & 7); }
struct SchedP2 {
    int G, c; const char* H; const char* W; size_t tstep;
    __device__ __forceinline__ bool next(int i, Unit& u) const {
        const long L = (long)i * G + c; if (L >= 1280) return false;
        if (L < 512) { u.kind = 0; pg8::decode_tile((int)L, 64, 8, u.pm, u.pn); } else { u.kind = 1; pg8::decode_tile((int)L - 512, 12, 64, u.pm, u.pn); }
        return true;
    }
    __device__ __forceinline__ const char* baseA(const Unit& u) const { return u.kind == 0 ? H + (size_t)u.pm * tstep : W + (size_t)(R_K / 256 + u.pm) * tstep; }
    __device__ __forceinline__ const char* baseB(const Unit& u) const { return u.kind == 0 ? W + (size_t)u.pn * tstep : H + (size_t)u.pn * tstep; }
};
struct EpiP2 {
    static constexpr bool PERM = true;
    bf16_t *Q, *Kk, *KT, *VT; const float *cosA, *sinA, *cosB, *sinB;
    __device__ __forceinline__ void operator()(const Acc& acc, const Unit& u, int wr, int wc, int fr, int fq) const {
        if (u.kind == 0) {
            const int head = u.pn & 3; const bool isK = u.pn >= 4; const float sc = isK ? 0.0625f : 1.0f;
            bf16_t* qbase = Q + ((((unsigned)((u.pm * 16 + wr * 4) * 4 + head) * 8 + wc) * 64 + fq * 16 + fr) * 8);
#pragma unroll
            for (int ai = 0; ai < 2; ++ai)
#pragma unroll
                for (int m = 0; m < 4; ++m) {
                    const int tok = u.pm * 256 + ai * 128 + wr * 64 + m * 16 + fr;
                    const int pos = (wc < 2) ? ((tok & (SEQ - 1)) >> 6) : (tok & 63);
                    f32x4 o1[2], o2[2];
#pragma unroll
                    for (int n = 0; n < 2; ++n) {
                        const int i0 = wc * 32 + fq * 8 + n * 4;
                        const f32x4 cs = *(const f32x4*)(cosA + pos * 64 + (i0 & 63)), sn = *(const f32x4*)(sinA + pos * 64 + (i0 & 63));
                        const f32x4 t1 = acc[ai][0][m][n], t2 = acc[ai][1][m][n];
                        o1[n] = (t1 * cs - t2 * sn) * sc; o2[n] = (t2 * cs + t1 * sn) * sc;
                    }
                    if (isK) { bf16_t* rp = Kk + (size_t)tok * 1024 + head * 256 + wc * 32 + fq * 8; *(u32x4*)rp = pk8(o1[0], o1[1]); *(u32x4*)(rp + 128) = pk8(o2[0], o2[1]); }
                    else { bf16_t* rp = qbase + (ai * 8 + m) * 16384; *(u32x4*)rp = pk8(o1[0], o1[1]); *(u32x4*)(rp + 2048) = pk8(o2[0], o2[1]); }
                }
        } else if (u.pm < 4) {
            bf16_t* ktbase = KT + (((((unsigned)((u.pn * 2) * 4 + u.pm) * 16 + wr * 4) * 4 + wc) * 64 + fq * 16 + fr) * 8);
#pragma unroll
            for (int m = 0; m < 4; ++m) {
                const int d = wr * 64 + m * 16 + fr;
#pragma unroll
                for (int bj = 0; bj < 2; ++bj) {
                    f32x4 o1[2], o2[2];
#pragma unroll
                    for (int n = 0; n < 2; ++n) {
                        const int tau = u.pn * 256 + bj * 128 + wc * 32 + fq * 8 + n * 4;
                        f32x4 cs, sn;
                        if (wr == 0) { const int pos = (tau & (SEQ - 1)) >> 6; const float c1 = cosA[pos * 64 + d], s1 = sinA[pos * 64 + d]; cs = (f32x4){c1, c1, c1, c1}; sn = (f32x4){s1, s1, s1, s1}; }
                        else { const int pos = tau & 63; cs = *(const f32x4*)(cosB + (d & 63) * 128 + pos); sn = *(const f32x4*)(sinB + (d & 63) * 128 + pos); }
                        const f32x4 t1 = acc[0][bj][m][n], t2 = acc[1][bj][m][n];
                        o1[n] = (t1 * cs - t2 * sn) * 0.0625f; o2[n] = (t2 * cs + t1 * sn) * 0.0625f;
                    }
                    bf16_t* rp = ktbase + bj * 131072 + m * 2048; *(u32x4*)rp = pk8(o1[0], o1[1]); *(u32x4*)(rp + 16384) = pk8(o2[0], o2[1]);
                }
            }
        } else {
#pragma unroll
            for (int ai = 0; ai < 2; ++ai)
#pragma unroll
                for (int m = 0; m < 4; ++m) {
                    bf16_t* rp = VT + (size_t)((u.pm - 4) * 256 + ai * 128 + wr * 64 + m * 16 + fr) * MALL + u.pn * 256 + wc * 32 + fq * 8;
#pragma unroll
                    for (int bj = 0; bj < 2; ++bj) *(u32x4*)(rp + bj * 128) = pk8(acc[ai][bj][m][0], acc[ai][bj][m][1]);
                }
        }
    }
};

struct EpiP6 {
    static constexpr bool PERM = true;
    bf16_t *O, *ARET, *ACONV, *GA, *GB; const float *cw, *cb, *ssq;
    __device__ __forceinline__ void operator()(const Acc& acc, const Unit& u, int wr, int wc, int fr, int fq) const {
        if (u.pn < 8) {
#pragma unroll
            for (int ai = 0; ai < 2; ++ai)
#pragma unroll
                for (int m = 0; m < 4; ++m) {
                    const int tokr = u.pm * 256 + ai * 128 + wr * 64 + m * 16 + fr;
                    const size_t off = (size_t)tokr * 2048 + u.pn * 256 + wc * 32 + fq * 8;
                    const f32x4* sp = (const f32x4*)(ssq + ((size_t)tokr * 4 + (u.pn >> 1)) * 16);
                    const f32x4 s0 = sp[0], s1 = sp[1], s2 = sp[2], s3 = sp[3];
                    const float ssum = (((s0[0] + s0[1]) + (s0[2] + s0[3])) + ((s1[0] + s1[1]) + (s1[2] + s1[3]))) + (((s2[0] + s2[1]) + (s2[2] + s2[3])) + ((s3[0] + s3[1]) + (s3[2] + s3[3])));
                    const float rstd = rsqrtf(ssum * (1.0f / 512.0f) + EPS);
#pragma unroll
                    for (int bj = 0; bj < 2; ++bj) {
                        const u32x4 ov = __builtin_nontemporal_load((const u32x4*)(O + ((((size_t)(u.pm * 2 + ai) * 4 + (u.pn >> 1)) * 16 + (u.pn & 1) * 8 + bj * 4 + wc) * 8 + wr * 4 + m) * 512 + (fq * 16 + fr) * 8));
                        const f32x4 o0 = unpk4((u32x2){ov.x, ov.y}), o1 = unpk4((u32x2){ov.z, ov.w}); const f32x4 g0 = acc[ai][bj][m][0], g1 = acc[ai][bj][m][1];
                        f32x4 r0, r1;
#pragma unroll
                        for (int j = 0; j < 4; ++j) { r0[j] = siluf_(g0[j]) * (o0[j] * rstd); r1[j] = siluf_(g1[j]) * (o1[j] * rstd); }
                        *(u32x4*)(ARET + off + bj * 128) = pk8(r0, r1);
                    }
                }
        } else if (u.pn < 24) {
            const int ch0 = (u.pn - 8) * 64 + wc * 16 + fq * 4;
            const f32x4 w0 = *(const f32x4*)(cw + ch0), w1 = *(const f32x4*)(cw + 1024 + ch0), w2 = *(const f32x4*)(cw + 2048 + ch0), bb = *(const f32x4*)(cb + ch0);
#pragma unroll
            for (int ai = 0; ai < 2; ++ai) {
                f32x4 uu[4];
#pragma unroll
                for (int m = 0; m < 4; ++m) uu[m] = acc[ai][0][m][0] * acc[ai][0][m][1];
#pragma unroll
                for (int m = 0; m < 4; ++m) {
                    f32x4 r, sg;
#pragma unroll
                    for (int j = 0; j < 4; ++j) {
                        const float up = up_nb(m > 0 ? uu[m - 1][j] : 0.f, uu[m][j]);
                        const float dn = dn_nb(m < 3 ? uu[m + 1][j] : 0.f, uu[m][j]);
                        r[j] = acc[ai][1][m][0][j] * (w0[j] * up + w1[j] * uu[m][j] + w2[j] * dn + bb[j]);
                        sg[j] = sigmoidf_(acc[ai][1][m][1][j]);
                    }
                    const size_t off = (size_t)(u.pm * 256 + ai * 128 + wr * 64 + m * 16 + fr) * 1024 + ch0;
                    *(u32x2*)(ACONV + off) = pk4(r); *(u32x2*)(GA + off) = pk4(sg);
                }
            }
        } else {
#pragma unroll
            for (int ai = 0; ai < 2; ++ai)
#pragma unroll
                for (int m = 0; m < 4; ++m) {
                    bf16_t* rp = GB + (size_t)(u.pm * 256 + ai * 128 + wr * 64 + m * 16 + fr) * 1024 + (u.pn - 24) * 256 + wc * 32 + fq * 8;
#pragma unroll
                    for (int bj = 0; bj < 2; ++bj) { const f32x4 g0 = acc[ai][bj][m][0], g1 = acc[ai][bj][m][1]; f32x4 r0, r1;
#pragma unroll
                        for (int j = 0; j < 4; ++j) { r0[j] = sigmoidf_(g0[j]); r1[j] = sigmoidf_(g1[j]); }
                        *(u32x4*)(rp + bj * 128) = pk8(r0, r1); }
                }
        }
    }
};
template <int MODE> struct EpiMix {
    static constexpr bool PERM = true;
    bf16_t* dst; const bf16_t* add; const bf16_t* mul;
    __device__ __forceinline__ void operator()(const Acc& acc, const Unit& u, int wr, int wc, int fr, int fq) const {
#pragma unroll
        for (int ai = 0; ai < 2; ++ai)
#pragma unroll
            for (int m = 0; m < 4; ++m) {
                const size_t off = (size_t)(u.pm * 256 + ai * 128 + wr * 64 + m * 16 + fr) * 1024 + u.pn * 256 + wc * 32 + fq * 8;
#pragma unroll
                for (int bj = 0; bj < 2; ++bj) {
                    const size_t o2 = off + bj * 128; f32x4 r0 = acc[ai][bj][m][0], r1 = acc[ai][bj][m][1];
                    if (MODE >= 1) { const u32x4 d = __builtin_nontemporal_load((const u32x4*)(mul + o2)); r0 = r0 * unpk4((u32x2){d.x, d.y}); r1 = r1 * unpk4((u32x2){d.z, d.w}); }
                    if (MODE == 2) { const u32x4 a = __builtin_nontemporal_load((const u32x4*)(add + o2)); r0 = r0 + unpk4((u32x2){a.x, a.y}); r1 = r1 + unpk4((u32x2){a.z, a.w}); }
                    *(u32x4*)(dst + o2) = pk8(r0, r1);
                }
            }
    }
};
struct EpiP11 {
    static constexpr bool PERM = true;
    bf16_t* AF; const float *cw, *cb;
    __device__ __forceinline__ void operator()(const Acc& acc, const Unit& u, int wr, int wc, int fr, int fq) const {
        u32x2 keep[8];
#pragma unroll
        for (int n = 0; n < 2; ++n) {
            const int ch0 = u.pn * 128 + wc * 32 + fq * 8 + n * 4;
            const f32x4 g0 = *(const f32x4*)(cw + ch0), g1 = *(const f32x4*)(cw + 2 * DFF + ch0), g2 = *(const f32x4*)(cw + 4 * DFF + ch0), gb = *(const f32x4*)(cb + ch0);
            const f32x4 v0 = *(const f32x4*)(cw + DFF + ch0), v1 = *(const f32x4*)(cw + 3 * DFF + ch0), v2 = *(const f32x4*)(cw + 5 * DFF + ch0), vb = *(const f32x4*)(cb + DFF + ch0);
#pragma unroll
            for (int s = 0; s < 8; ++s) {
                f32x4 r;
#pragma unroll
                for (int j = 0; j < 4; ++j) {
                    const float cg_ = acc[s >> 2][0][s & 3][n][j], cv_ = acc[s >> 2][1][s & 3][n][j];
                    const float ugp = up_nb(s > 0 ? acc[(s - 1) >> 2][0][(s - 1) & 3][n][j] : 0.f, cg_);
                    const float ugn = dn_nb(s < 7 ? acc[(s + 1) >> 2][0][(s + 1) & 3][n][j] : 0.f, cg_);
                    const float uvp = up_nb(s > 0 ? acc[(s - 1) >> 2][1][(s - 1) & 3][n][j] : 0.f, cv_);
                    const float uvn = dn_nb(s < 7 ? acc[(s + 1) >> 2][1][(s + 1) & 3][n][j] : 0.f, cv_);
                    const float ug = g0[j] * ugp + g1[j] * cg_ + g2[j] * ugn + gb[j];
                    const float uv = v0[j] * uvp + v1[j] * cv_ + v2[j] * uvn + vb[j];
                    r[j] = siluf_(ug) * uv;
                }
                if (n == 0) keep[s] = pk4(r);
                else { const u32x2 hi = pk4(r); u32x4 o; o.x = keep[s].x; o.y = keep[s].y; o.z = hi.x; o.w = hi.y;
                    *(u32x4*)(AF + (size_t)(u.pm * 256 + (s >> 2) * 128 + wr * 64 + (s & 3) * 16 + fr) * DFF + u.pn * 128 + wc * 32 + fq * 8) = o; }
            }
        }
    }
};
struct EpiP12 {
    static constexpr bool PERM = true;
    bf16_t* F;
    __device__ __forceinline__ void operator()(const Acc& acc, const Unit& u, int wr, int wc, int fr, int fq) const {
        const int b = u.pm >> 5, gc = (u.pm & 31) * 2 + wr;
#pragma unroll
        for (int ai = 0; ai < 2; ++ai)
#pragma unroll
            for (int m = 0; m < 4; ++m) {
                const int tok = b * SEQ + (ai * 64 + m * 16 + fr) * 64 + gc;
                bf16_t* rp = F + (size_t)tok * 1024 + u.pn * 256 + wc * 32 + fq * 8;
#pragma unroll
                for (int bj = 0; bj < 2; ++bj) *(u32x4*)(rp + bj * 128) = pk8(acc[ai][bj][m][0], acc[ai][bj][m][1]);
            }
    }
};

struct RowMapId { int off; __device__ __forceinline__ int operator()(int n) const { return off + n; } };
struct RowMapIn {
    __device__ __forceinline__ int operator()(int n) const {
        int s, ch;
        if (n < S_Q) { if (n < S_CB) { s = 0; ch = n; } else if (n < S_CC) { s = 2; ch = n - S_CB; } else { s = 1; ch = n - S_CC; } }
        else if (n < S_K) return R_Q + (n - S_Q);
        else if (n < S_V) return R_K + (n - S_K);
        else if (n < S_G) return R_V + (n - S_V);
        else if (n < S_GA) return R_G + (n - S_G);
        else if (n < S_GB) { s = 3; ch = n - S_GA; }
        else return R_GB + (n - S_GB);
        const int cl = ch & 63;
        return R_C + 256 * (ch >> 6) + 128 * (s >> 1) + 32 * (cl >> 4) + 8 * ((cl >> 2) & 3) + 4 * (s & 1) + (cl & 3);
    }
};
struct RowMapUp { __device__ __forceinline__ int operator()(int n) const { const int v = n >= DFF, ch = v ? n - DFF : n; return 256 * (ch >> 7) + 128 * v + (ch & 127); } };

template <class RowMap>
__device__ __forceinline__ void transpose_item(const float* W, int K, int N, bf16_t* WT, const RowMap rm, LAS float* scr, int item, int lane) {
    const int nblk = N / 32, kb = item / nblk, nb = item % nblk, k0 = 64 * kb, n0 = 32 * nb;
    float tv[32];
#pragma unroll
    for (int i = 0; i < 32; ++i) tv[i] = __builtin_nontemporal_load(W + (size_t)(k0 + 2 * i + (lane >> 5)) * N + n0 + (lane & 31));
#pragma unroll
    for (int i = 0; i < 32; ++i) scr[(2 * i + (lane >> 5)) * 33 + (lane & 31)] = tv[i];
    asm volatile("s_waitcnt lgkmcnt(0)" ::: "memory");
    const int c = lane & 7;
#pragma unroll
    for (int j = 0; j < 4; ++j) { const int n = (lane >> 3) + 8 * j; const LAS float* s = scr + (8 * c) * 33 + n;
        u32x4 o; o.x = cvt_pk_bf16(s[0 * 33], s[1 * 33]); o.y = cvt_pk_bf16(s[2 * 33], s[3 * 33]); o.z = cvt_pk_bf16(s[4 * 33], s[5 * 33]); o.w = cvt_pk_bf16(s[6 * 33], s[7 * 33]);
        *(u32x4*)(WT + (size_t)rm(n0 + n) * K + k0 + 8 * c) = o; }
    asm volatile("s_waitcnt lgkmcnt(0)" ::: "memory");
}

__device__ __forceinline__ void phase0(const Params& p, LAS unsigned char* lds, int blk, int G) {
    const int tid = threadIdx.x, lane = tid & 63, wave = tid >> 6;
    float* small = (float*)(p.ws + OFF_SMALL);
    for (int i = blk * 512 + tid; i < 8192; i += G * 512) {
        const int pos = i >> 6, f = i & 63; const float inv = powf(10000.0f, -(float)f / 64.0f), ang = (float)pos * inv; const float cs = cosf(ang), sn = sinf(ang);
        ((float*)(p.ws + OFF_SMALL + SM_COSA))[pos * 64 + f] = cs; ((float*)(p.ws + OFF_SMALL + SM_SINA))[pos * 64 + f] = sn;
        ((float*)(p.ws + OFF_SMALL + SM_COSB))[f * 128 + pos] = cs; ((float*)(p.ws + OFF_SMALL + SM_SINB))[f * 128 + pos] = sn;
    }
    if (blk == 0 && tid < 8) {
        const float th = (tid < 4) ? p.in[12][tid] : p.in[13][tid - 4];
        const float lg = -(th > 0.f ? log1pf(expf(-th)) : (-th + log1pf(expf(th))));
        ((float*)(p.ws + OFF_SMALL + SM_DEC))[tid] = lg * 1.4426950408889634f;
    }
    if (blk < 96) {
        LAS float* sv = (LAS float*)lds; LAS float* red = sv + 3 * 1024;
        for (int i = tid; i < 3 * 1024; i += 512) { const int v = i >> 10, k = i & 1023; const float cv = (v < 2) ? p.in[1][v * 1024 + k] : p.in[3][k]; sv[i] = siluf_(cv); }
        __syncthreads();
        for (int item = blk; item < 96; item += G) {
            const int kg = tid >> 6, col = item * 64 + (tid & 63); const float* wp = p.in[4] + (size_t)(kg * 128) * 6144 + col;
            float a0 = 0.f, a1 = 0.f, a2 = 0.f;
#pragma unroll 32
            for (int k = 0; k < 128; ++k) { const float w = __builtin_nontemporal_load(wp + (size_t)k * 6144); a0 += sv[kg * 128 + k] * w; a1 += sv[1024 + kg * 128 + k] * w; a2 += sv[2048 + kg * 128 + k] * w; }
            red[(kg * 64 + (tid & 63)) * 3 + 0] = a0; red[(kg * 64 + (tid & 63)) * 3 + 1] = a1; red[(kg * 64 + (tid & 63)) * 3 + 2] = a2;
            __syncthreads();
            if (tid < 192) { const int v = tid >> 6, cl = tid & 63; float s = p.in[5][item * 64 + cl];
#pragma unroll
                for (int g = 0; g < 8; ++g) s += red[(g * 64 + cl) * 3 + v];
                small[SM_MOD / 4 + v * 6144 + item * 64 + cl] = s; }
            __syncthreads();
        }
    }
    LAS float* scr = (LAS float*)(lds + wave * 8704);
    const int gw = blk * 8 + wave, NGW = G * 8;
    constexpr int I_IN = 16 * (INC / 32), I_CO = 16 * 32, I_RO = 32 * 32, I_O = 16 * 32, I_UP = 16 * (2 * DFF / 32), I_DN = (DFF / 64) * 32;
    constexpr int NITEMS = I_IN + I_CO + I_RO + I_O + I_UP + I_DN;
    for (int it = gw; it < NITEMS; it += NGW) {
        int r = it;
        if (r < I_IN) { transpose_item(p.in[8], 1024, INC, (bf16_t*)(p.ws + OFF_WT_IN), RowMapIn{}, scr, r, lane); continue; } r -= I_IN;
        if (r < I_CO) { transpose_item(p.in[11], 1024, 1024, (bf16_t*)(p.ws + OFF_WT_CO), RowMapId{0}, scr, r, lane); continue; } r -= I_CO;
        if (r < I_RO) { transpose_item(p.in[14], 2048, 1024, (bf16_t*)(p.ws + OFF_WT_RO), RowMapId{0}, scr, r, lane); continue; } r -= I_RO;
        if (r < I_O) { transpose_item(p.in[15], 1024, 1024, (bf16_t*)(p.ws + OFF_WT_O), RowMapId{0}, scr, r, lane); continue; } r -= I_O;
        if (r < I_UP) { transpose_item(p.in[18], 1024, 2 * DFF, (bf16_t*)(p.ws + OFF_WT_UP), RowMapUp{}, scr, r, lane); continue; } r -= I_UP;
        transpose_item(p.in[21], DFF, 1024, (bf16_t*)(p.ws + OFF_WT_DN), RowMapId{0}, scr, r, lane);
    }
}

__device__ __forceinline__ void phase1(const Params& p, int blk, int G) {
    const int lane = threadIdx.x & 63, gw = blk * 8 + (threadIdx.x >> 6), NGW = G * 8;
    const float* mod = (const float*)(p.ws + OFF_SMALL + SM_MOD); bf16_t* H = (bf16_t*)(p.ws + OFF_H);
    auto rowsrc = [&](int row) { return row < MTOK ? p.in[0] + (size_t)row * 1024 : p.in[2] + (size_t)(row - MTOK) * 1024; };
    f32x4 x[4], xn[4];
    if (gw < MALL) { const float* s = rowsrc(gw);
#pragma unroll
        for (int j = 0; j < 4; ++j) x[j] = __builtin_nontemporal_load((const f32x4*)(s + 4 * lane + 256 * j)); }
    for (int row = gw; row < MALL; row += NGW) {
        const int nrow = row + NGW;
        if (nrow < MALL) { const float* s = rowsrc(nrow);
#pragma unroll
            for (int j = 0; j < 4; ++j) xn[j] = __builtin_nontemporal_load((const f32x4*)(s + 4 * lane + 256 * j)); }
        const int v = row < MTOK ? (row >> 13) : 2; const float* sh = mod + v * 6144; const float* scl = sh + 1024;
        float ss = 0.f;
#pragma unroll
        for (int j = 0; j < 4; ++j) ss += (x[j][0] * x[j][0] + x[j][1] * x[j][1]) + (x[j][2] * x[j][2] + x[j][3] * x[j][3]);
        const float rs = rsqrtf(wave_sum(ss) * (1.0f / 1024.0f) + EPS);
#pragma unroll
        for (int j = 0; j < 4; ++j) { const int c = 4 * lane + 256 * j; const f32x4 g = *(const f32x4*)(p.in[6] + c), s1 = *(const f32x4*)(scl + c), s0 = *(const f32x4*)(sh + c);
            const f32x4 r = (x[j] * rs) * g * (s1 + 1.0f) + s0; *(u32x2*)(H + (size_t)row * 1024 + c) = pk4(r); }
#pragma unroll
        for (int j = 0; j < 4; ++j) x[j] = xn[j];
    }
}

#define LDS_BARRIER() do { asm volatile("s_waitcnt lgkmcnt(0)" ::: "memory"); __builtin_amdgcn_s_barrier(); asm volatile("" ::: "memory"); } while (0)
#define MFMA16(a, b, c) __builtin_amdgcn_mfma_f32_16x16x32_bf16((a), (b), (c), 0, 0, 0)
__device__ __forceinline__ void phase3(const Params& p, LAS unsigned char* lds, int blk, int G) {
    const int tid = threadIdx.x, lane = tid & 63, w = tid >> 6, fr = lane & 15, fq = lane >> 4;
    const bf16_t* Q = (const bf16_t*)p.out; const bf16_t* Kk = (const bf16_t*)p.out + (size_t)MTOK * 1024; const bf16_t* VT = (const bf16_t*)(p.ws + OFF_VT);
    bf16_t* O = (bf16_t*)(p.ws + OFF_O); const float* dec = (const float*)(p.ws + OFF_SMALL + SM_DEC);
    LAS bf16_t* Kl = (LAS bf16_t*)lds;
    LAS bf16_t* Vl = (LAS bf16_t*)(lds + 67584);
    LAS bf16_t* Pl = (LAS bf16_t*)(lds + w * 4352);
    {
        const bf16_t* Hc = (const bf16_t*)(p.ws + OFF_H) + (size_t)MTOK * 1024; const bf16_t* Wkv = (const bf16_t*)(p.ws + OFF_WT_IN) + (size_t)R_K * 1024;
        bf16_t* KTo = (bf16_t*)(p.ws + OFF_KT); bf16_t* VTo = (bf16_t*)(p.ws + OFF_VT);
        for (int t = blk * 8 + w; t < 96 * 16; t += G * 8) {
            const int row0 = (t >> 4) * 32, tok0 = (t & 15) * 32;
            f32x4 a[2][2];
#pragma unroll
            for (int i = 0; i < 2; ++i)
#pragma unroll
                for (int j = 0; j < 2; ++j) a[i][j] = (f32x4){0.f, 0.f, 0.f, 0.f};
            const bf16_t* hp = Hc + (size_t)(tok0 + fr) * 1024 + 8 * fq; const bf16_t* wp = Wkv + (size_t)(row0 + fr) * 1024 + 8 * fq;
#pragma unroll 8
            for (int ks = 0; ks < 32; ++ks) {
                const bf16x8 h0 = *(const bf16x8*)(hp + 32 * ks), h1 = *(const bf16x8*)(hp + 16 * 1024 + 32 * ks);
                const bf16x8 w0 = *(const bf16x8*)(wp + 32 * ks), w1 = *(const bf16x8*)(wp + 16 * 1024 + 32 * ks);
                a[0][0] = MFMA16(h0, w0, a[0][0]); a[0][1] = MFMA16(h1, w0, a[0][1]); a[1][0] = MFMA16(h0, w1, a[1][0]); a[1][1] = MFMA16(h1, w1, a[1][1]);
            }
#pragma unroll
            for (int i = 0; i < 2; ++i)
#pragma unroll
                for (int j = 0; j < 2; ++j) {
                    const int row = row0 + 16 * i + fr, tau = MTOK + tok0 + 16 * j + 4 * fq;
                    if (row < 1024) *(u32x2*)(KTo + ktf_idx(row, tau)) = pk4(a[i][j] * 0.0625f);
                    else *(u32x2*)(VTo + (size_t)(row - 1024) * MALL + tau) = pk4(a[i][j]);
                }
        }
    }
    for (int it = 0; it < (G == 256 ? 2 : (512 + G - 1) / G); ++it) {
        const int item = (G == 256) ? ((blk & 7) * 64 + (blk >> 3) + 32 * it) : (blk + it * G);
        if (item >= 512) break;
        const int c = item & 63, h = (item >> 6) & 3, b = item >> 8; const int t0 = b * SEQ + c * 128;
        const float lf = dec[h], lb = dec[4 + h];
        const float di = (float)(16 * w + fr - 4 * fq);
#pragma unroll
        for (int i = 0; i < 8; ++i) { const int idx = tid + 512 * i, row = idx >> 5, pc = idx & 31;
            *(LAS u32x4*)(Kl + row * 264 + pc * 8) = __builtin_nontemporal_load((const u32x4*)(Kk + (size_t)(t0 + row) * 1024 + h * 256 + pc * 8)); }
#pragma unroll
        for (int i = 0; i < 8; ++i) { const int idx = tid + 512 * i, row = idx >> 4, pc = idx & 15;
            *(LAS u32x4*)(Vl + row * 136 + pc * 8) = *(const u32x4*)(VT + (size_t)(h * 512 + (row & ~31) + 8 * ((row >> 2) & 3) + 4 * ((row >> 4) & 1) + (row & 3)) * MALL + t0 + pc * 8); }
        bf16x8 qf[8];
#pragma unroll
        for (int ks = 0; ks < 8; ++ks) qf[ks] = *(const bf16x8*)(Q + ((((size_t)((t0 >> 4) + w) * 4 + h) * 8 + ks) * 64 + lane) * 8);
        __syncthreads();
        u32x4 vnext[8];
#pragma unroll
        for (int i = 0; i < 8; ++i) { const int idx = tid + 512 * i, row = idx >> 4, pc = idx & 15;
            vnext[i] = *(const u32x4*)(VT + (size_t)(h * 512 + 256 + (row & ~31) + 8 * ((row >> 2) & 3) + 4 * ((row >> 4) & 1) + (row & 3)) * MALL + t0 + pc * 8); }
        u32x2 pr[8];
#pragma unroll
        for (int nt = 0; nt < 8; ++nt) {
            f32x4 a = (f32x4){0.f, 0.f, 0.f, 0.f};
#pragma unroll
            for (int ks = 0; ks < 8; ++ks) { const bf16x8 kf = *(const LAS bf16x8*)(Kl + (16 * nt + fr) * 264 + 32 * ks + 8 * fq); a = MFMA16(kf, qf[ks], a); }
            f32x4 r;
#pragma unroll
            for (int e = 0; e < 4; ++e) { const float dd = di - (float)(16 * nt + e); const float dm = __builtin_amdgcn_exp2f(dd >= 0.f ? lf * dd : -lb * dd); r[e] = a[e] * dm; }
            pr[nt] = pk4(r);
        }
        LDS_BARRIER();
#pragma unroll
        for (int nt = 0; nt < 8; ++nt) *(LAS u32x2*)(Pl + fr * 136 + 16 * nt + 4 * fq) = pr[nt];
        asm volatile("s_waitcnt lgkmcnt(0)" ::: "memory");
        bf16x8 pf[4];
#pragma unroll
        for (int ks = 0; ks < 4; ++ks) pf[ks] = *(const LAS bf16x8*)(Pl + fr * 136 + 32 * ks + 8 * fq);
#pragma unroll 1
        for (int half = 0; half < 2; ++half) {
            if (half == 1) {
                LDS_BARRIER();
#pragma unroll
                for (int i = 0; i < 8; ++i) { const int idx = tid + 512 * i, row = idx >> 4, pc = idx & 15; *(LAS u32x4*)(Vl + row * 136 + pc * 8) = vnext[i]; }
                LDS_BARRIER();
            }
            f32x4 oa[16];
#pragma unroll
            for (int nt = 0; nt < 16; ++nt) oa[nt] = (f32x4){0.f, 0.f, 0.f, 0.f};
#pragma unroll
            for (int ks = 0; ks < 4; ++ks)
#pragma unroll
                for (int nt = 0; nt < 16; ++nt) { const bf16x8 vf = *(const LAS bf16x8*)(Vl + (16 * nt + fr) * 136 + 32 * ks + 8 * fq); oa[nt] = MFMA16(vf, pf[ks], oa[nt]); }
            bf16_t* rp = O + (((((size_t)(t0 >> 7) * 4 + h) * 16 + half * 8) * 8 + w) * 512) + lane * 8;
#pragma unroll
            for (int g = 0; g < 8; ++g) *(u32x4*)(rp + (size_t)g * 8 * 512) = pk8(oa[2 * g], oa[2 * g + 1]);
        }
        __syncthreads();
    }
}

__device__ __forceinline__ int p4_col0(int s, int b, int dir) { return s < 2 ? MTOK + b * CTXL + (dir == 0 ? s : 1 - s) * 128 : b * SEQ + (dir == 0 ? s - 2 : 65 - s) * 128; }
__device__ __forceinline__ void phase4(const Params& p, LAS unsigned char* lds, int blk, int G, int s_lo, int s_hi) {
    const int tid = threadIdx.x, lane = tid & 63, w = tid >> 6, fr = lane & 15, fq = lane >> 4;
    const bf16_t* Q = (const bf16_t*)p.out; const bf16_t* KT = (const bf16_t*)(p.ws + OFF_KT); const bf16_t* VT = (const bf16_t*)(p.ws + OFF_VT);
    bf16_t* O = (bf16_t*)(p.ws + OFF_O); const float* dec = (const float*)(p.ws + OFF_SMALL + SM_DEC); float* ssave = (float*)(p.ws + OFF_SSAVE);
    float* ssq = (float*)(p.ws + OFF_SSQP);
    LAS bf16_t* Sb = (LAS bf16_t*)lds;
    LAS bf16_t* Vz = (LAS bf16_t*)(lds + 33792);
    for (int item = blk; item < 256; item += G) {
        const int xcd = item & 7, y = item >> 3, chain = xcd * 2 + (y & 1), slice = y >> 1;
        const int dir = chain & 1, h = (chain >> 1) & 3, b = chain >> 3;
        const float lg = dec[dir * 4 + h];
        const float dec128 = exp2f(lg * 128.0f);
        const int irow = 16 * w + fr; const float xi = exp2f(lg * (float)(dir == 0 ? irow + 1 : 128 - irow));
        const int vrow = tid >> 4, vpc = tid & 15;
        float zv[8];
#pragma unroll
        for (int e = 0; e < 8; ++e) { const int j = 8 * vpc + e; zv[e] = exp2f(lg * (float)(dir == 0 ? 127 - j : j)); }
        const bf16_t* vsrc = VT + (size_t)(h * 512 + slice * 32 + 8 * ((vrow >> 2) & 3) + 4 * (vrow >> 4) + (vrow & 3)) * MALL + 8 * vpc;
        const bf16_t* ksrc = KT + (size_t)lane * 8;
        const bf16_t* qsrc = Q + (size_t)lane * 8;
        bf16_t* osrc = O + (size_t)lane * 8;
#define P4_OT(c) (((((size_t)((c) >> 7) * 4 + h) * 16 + slice) * 8 + w) * 512)
        f32x4 Sa[2][2];
        if (s_lo == 0) {
#pragma unroll
            for (int mt = 0; mt < 2; ++mt)
#pragma unroll
                for (int nt = 0; nt < 2; ++nt) Sa[mt][nt] = (f32x4){0.f, 0.f, 0.f, 0.f};
        } else {
#pragma unroll
            for (int mt = 0; mt < 2; ++mt)
#pragma unroll
                for (int nt = 0; nt < 2; ++nt) Sa[mt][nt] = *(const f32x4*)(ssave + ((size_t)(item * 512 + tid) * 4 + mt * 2 + nt) * 4);
        }
        bf16x8 qc[8], kc[2][4]; u32x4 oold; u32x4 vraw;
        {
            const int c0 = p4_col0(s_lo, b, dir);
            const u32x4 v0 = *(const u32x4*)(vsrc + c0);
#pragma unroll
            for (int mt = 0; mt < 2; ++mt)
#pragma unroll
                for (int ks = 0; ks < 4; ++ks) kc[mt][ks] = *(const bf16x8*)(ksrc + (((((size_t)(c0 >> 7) * 4 + h) * 16 + (2 * w + mt)) * 4 + ks) * 512));
            if (s_lo >= 2) {
#pragma unroll
                for (int ks = 0; ks < 8; ++ks) qc[ks] = *(const bf16x8*)(qsrc + ((((size_t)((c0 >> 4) + w) * 4 + h) * 8 + ks) * 512));
                oold = *(const u32x4*)(osrc + P4_OT(c0));
            } else {
#pragma unroll
                for (int ks = 0; ks < 8; ++ks) qc[ks] = (bf16x8){0, 0, 0, 0, 0, 0, 0, 0};
                oold = (u32x4){0u, 0u, 0u, 0u};
            }
            vraw = (s_lo + 1 < s_hi) ? *(const u32x4*)(vsrc + p4_col0(s_lo + 1, b, dir)) : v0;
            LDS_BARRIER();
            const int buf = s_lo & 1;
#pragma unroll
            for (int mt = 0; mt < 2; ++mt)
#pragma unroll
                for (int nt = 0; nt < 2; ++nt) *(LAS u32x2*)(Sb + buf * 8448 + (16 * nt + fr) * 264 + 32 * w + 16 * mt + 4 * fq) = pk4(Sa[mt][nt]);
            u32x4 vs; vs.x = cvt_pk_bf16(bf_lo(v0.x) * zv[0], bf_hi(v0.x) * zv[1]); vs.y = cvt_pk_bf16(bf_lo(v0.y) * zv[2], bf_hi(v0.y) * zv[3]);
            vs.z = cvt_pk_bf16(bf_lo(v0.z) * zv[4], bf_hi(v0.z) * zv[5]); vs.w = cvt_pk_bf16(bf_lo(v0.w) * zv[6], bf_hi(v0.w) * zv[7]);
            *(LAS u32x4*)(Vz + buf * 4352 + vrow * 136 + 8 * vpc) = vs;
            LDS_BARRIER();
        }
        for (int s = s_lo; s < s_hi; ++s) {
            const int buf = s & 1; const bool lat = s >= 2, has1 = s + 1 < s_hi, lat1 = has1 && (s + 1 >= 2);
            const int c0 = p4_col0(s, b, dir), c1 = has1 ? p4_col0(s + 1, b, dir) : c0;
            f32x4 oa[2] = {(f32x4){0.f, 0.f, 0.f, 0.f}, (f32x4){0.f, 0.f, 0.f, 0.f}};
            if (lat) {
                f32x4 ob[2] = {(f32x4){0.f, 0.f, 0.f, 0.f}, (f32x4){0.f, 0.f, 0.f, 0.f}};
#pragma unroll
                for (int ks = 0; ks < 8; ks += 2)
#pragma unroll
                    for (int nt = 0; nt < 2; ++nt) {
                        const bf16x8 s0 = *(const LAS bf16x8*)(Sb + buf * 8448 + (16 * nt + fr) * 264 + 32 * ks + 8 * fq), s1 = *(const LAS bf16x8*)(Sb + buf * 8448 + (16 * nt + fr) * 264 + 32 * (ks + 1) + 8 * fq);
                        oa[nt] = MFMA16(s0, qc[ks], oa[nt]); ob[nt] = MFMA16(s1, qc[ks + 1], ob[nt]); }
                oa[0] = oa[0] + ob[0]; oa[1] = oa[1] + ob[1];
            }
            bf16x8 qn[8];
            if (lat1) {
#pragma unroll
                for (int ks = 0; ks < 8; ++ks) qn[ks] = *(const bf16x8*)(qsrc + ((((size_t)((c1 >> 4) + w) * 4 + h) * 8 + ks) * 512));
            } else {
#pragma unroll
                for (int ks = 0; ks < 8; ++ks) qn[ks] = qc[ks];
            }
            f32x4 U[2][2];
#pragma unroll
            for (int mt = 0; mt < 2; ++mt)
#pragma unroll
                for (int nt = 0; nt < 2; ++nt) U[mt][nt] = (f32x4){0.f, 0.f, 0.f, 0.f};
#pragma unroll
            for (int ks = 0; ks < 4; ++ks) {
                bf16x8 vf[2];
#pragma unroll
                for (int nt = 0; nt < 2; ++nt) vf[nt] = *(const LAS bf16x8*)(Vz + buf * 4352 + (16 * nt + fr) * 136 + 32 * ks + 8 * fq);
#pragma unroll
                for (int mt = 0; mt < 2; ++mt)
#pragma unroll
                    for (int nt = 0; nt < 2; ++nt) U[mt][nt] = MFMA16(kc[mt][ks], vf[nt], U[mt][nt]);
            }
            bf16x8 kn[2][4];
#pragma unroll
            for (int mt = 0; mt < 2; ++mt)
#pragma unroll
                for (int ks = 0; ks < 4; ++ks) kn[mt][ks] = has1 ? *(const bf16x8*)(ksrc + (((((size_t)(c1 >> 7) * 4 + h) * 16 + (2 * w + mt)) * 4 + ks) * 512)) : kc[mt][ks];
#pragma unroll
            for (int mt = 0; mt < 2; ++mt)
#pragma unroll
                for (int nt = 0; nt < 2; ++nt) { Sa[mt][nt] = Sa[mt][nt] * dec128 + U[mt][nt];
                    *(LAS u32x2*)(Sb + (buf ^ 1) * 8448 + (16 * nt + fr) * 264 + 32 * w + 16 * mt + 4 * fq) = pk4(Sa[mt][nt]); }
            if (has1) {
                u32x4 vs; vs.x = cvt_pk_bf16(bf_lo(vraw.x) * zv[0], bf_hi(vraw.x) * zv[1]); vs.y = cvt_pk_bf16(bf_lo(vraw.y) * zv[2], bf_hi(vraw.y) * zv[3]);
                vs.z = cvt_pk_bf16(bf_lo(vraw.z) * zv[4], bf_hi(vraw.z) * zv[5]); vs.w = cvt_pk_bf16(bf_lo(vraw.w) * zv[6], bf_hi(vraw.w) * zv[7]);
                *(LAS u32x4*)(Vz + (buf ^ 1) * 4352 + vrow * 136 + 8 * vpc) = vs;
            }
            if (s + 2 < s_hi) vraw = *(const u32x4*)(vsrc + p4_col0(s + 2, b, dir));
            if (lat) {
                float sq = 0.f;
                const u32x2 o0 = pk4(unpk4((u32x2){oold.x, oold.y}) + oa[0] * xi), o1 = pk4(unpk4((u32x2){oold.z, oold.w}) + oa[1] * xi);
                { u32x4 ov; ov.x = o0.x; ov.y = o0.y; ov.z = o1.x; ov.w = o1.y; *(u32x4*)(osrc + P4_OT(c0)) = ov; }
                { const f32x4 f0 = unpk4(o0), f1 = unpk4(o1); sq = ((f0[0] * f0[0] + f0[1] * f0[1]) + (f0[2] * f0[2] + f0[3] * f0[3])) + ((f1[0] * f1[0] + f1[1] * f1[1]) + (f1[2] * f1[2] + f1[3] * f1[3])); }
                if (s_lo != 0) {
                    sq += __shfl_xor(sq, 16); sq += __shfl_xor(sq, 32);
                    if (fq == 0) ssq[((size_t)(c0 + irow) * 4 + h) * 16 + slice] = sq;
                }
            }
            if (lat1) oold = *(const u32x4*)(osrc + P4_OT(c1));
            LDS_BARRIER();
#pragma unroll
            for (int ks = 0; ks < 8; ++ks) qc[ks] = qn[ks];
#pragma unroll
            for (int mt = 0; mt < 2; ++mt)
#pragma unroll
                for (int ks = 0; ks < 4; ++ks) kc[mt][ks] = kn[mt][ks];
        }
#pragma unroll
        for (int mt = 0; mt < 2; ++mt)
#pragma unroll
            for (int nt = 0; nt < 2; ++nt) *(f32x4*)(ssave + ((size_t)(item * 512 + tid) * 4 + mt * 2 + nt) * 4) = Sa[mt][nt];
    }
}

__device__ __forceinline__ void phase5(const Params& p, int blk, int G) {
    const int lane = threadIdx.x & 63; bf16_t* O = (bf16_t*)p.out;
    for (int r = blk * 8 + (threadIdx.x >> 6); r < MTOK * 4; r += G * 8) {
        u32x4* pp = (u32x4*)(O + (size_t)r * 512 + lane * 8); const u32x4 v = *pp;
        float f[8] = {bf_lo(v.x), bf_hi(v.x), bf_lo(v.y), bf_hi(v.y), bf_lo(v.z), bf_hi(v.z), bf_lo(v.w), bf_hi(v.w)};
        float ss = 0.f;
#pragma unroll
        for (int e = 0; e < 8; ++e) ss += f[e] * f[e];
        const float rs = rsqrtf(wave_sum(ss) * (1.0f / 512.0f) + EPS);
        u32x4 o; o.x = cvt_pk_bf16(f[0] * rs, f[1] * rs); o.y = cvt_pk_bf16(f[2] * rs, f[3] * rs); o.z = cvt_pk_bf16(f[4] * rs, f[5] * rs); o.w = cvt_pk_bf16(f[6] * rs, f[7] * rs);
        *pp = o;
    }
}

__device__ __forceinline__ void phase10(const Params& p, int blk, int G) {
    const int lane = threadIdx.x & 63; const float* mod = (const float*)(p.ws + OFF_SMALL + SM_MOD);
    const bf16_t* Y = (const bf16_t*)(p.ws + OFF_Y); bf16_t* H2 = (bf16_t*)(p.ws + OFF_H);
    const int gw = blk * 8 + (threadIdx.x >> 6), NGW = G * 8;
    u32x2 yr[4], yrn[4]; f32x4 xv[4], xvn[4];
    if (gw < MTOK) {
#pragma unroll
        for (int j = 0; j < 4; ++j) { yr[j] = __builtin_nontemporal_load((const u32x2*)(Y + (size_t)gw * 1024 + 4 * lane + 256 * j)); xv[j] = __builtin_nontemporal_load((const f32x4*)(p.in[0] + (size_t)gw * 1024 + 4 * lane + 256 * j)); } }
    for (int row = gw; row < MTOK; row += NGW) {
        const int nrow = row + NGW;
        if (nrow < MTOK) {
#pragma unroll
            for (int j = 0; j < 4; ++j) { yrn[j] = __builtin_nontemporal_load((const u32x2*)(Y + (size_t)nrow * 1024 + 4 * lane + 256 * j)); xvn[j] = __builtin_nontemporal_load((const f32x4*)(p.in[0] + (size_t)nrow * 1024 + 4 * lane + 256 * j)); } }
        const int b = row >> 13; const float* md = mod + b * 6144;
        f32x4 y[4], x1[4]; float ss = 0.f;
#pragma unroll
        for (int j = 0; j < 4; ++j) { y[j] = unpk4(yr[j]); ss += (y[j][0] * y[j][0] + y[j][1] * y[j][1]) + (y[j][2] * y[j][2] + y[j][3] * y[j][3]); }
        const float rs = rsqrtf(wave_sum(ss) * (1.0f / 1024.0f) + EPS); float s2 = 0.f;
#pragma unroll
        for (int j = 0; j < 4; ++j) { const int c = 4 * lane + 256 * j; const f32x4 g = *(const f32x4*)(p.in[7] + c), gt = *(const f32x4*)(md + 2048 + c);
            x1[j] = xv[j] + gt * ((y[j] * rs) * g); *(f32x4*)(p.out + (size_t)row * 1024 + c) = x1[j];
            s2 += (x1[j][0] * x1[j][0] + x1[j][1] * x1[j][1]) + (x1[j][2] * x1[j][2] + x1[j][3] * x1[j][3]); }
        const float rs2 = rsqrtf(wave_sum(s2) * (1.0f / 1024.0f) + EPS);
        const int t = row & (SEQ - 1), gr = t >> 6, gc = t & 63; const int mu = 256 * (b * 32 + (gc >> 1)) + 128 * (gr >> 6) + 64 * (gc & 1) + (gr & 63);
#pragma unroll
        for (int j = 0; j < 4; ++j) { const int c = 4 * lane + 256 * j; const f32x4 g = *(const f32x4*)(p.in[16] + c), s1 = *(const f32x4*)(md + 4096 + c), s0 = *(const f32x4*)(md + 3072 + c);
            const f32x4 r = (x1[j] * rs2) * g * (s1 + 1.0f) + s0; *(u32x2*)(H2 + (size_t)mu * 1024 + c) = pk4(r); }
#pragma unroll
        for (int j = 0; j < 4; ++j) { yr[j] = yrn[j]; xv[j] = xvn[j]; }
    }
}
__device__ __forceinline__ void phase13(const Params& p, int blk, int G) {
    const int lane = threadIdx.x & 63; const float* mod = (const float*)(p.ws + OFF_SMALL + SM_MOD); const bf16_t* F = (const bf16_t*)(p.ws + OFF_F);
    const int gw = blk * 8 + (threadIdx.x >> 6), NGW = G * 8;
    u32x2 fr_[4], frn[4]; f32x4 ov[4], ovn[4];
    if (gw < MTOK) {
#pragma unroll
        for (int j = 0; j < 4; ++j) { fr_[j] = __builtin_nontemporal_load((const u32x2*)(F + (size_t)gw * 1024 + 4 * lane + 256 * j)); ov[j] = __builtin_nontemporal_load((const f32x4*)(p.out + (size_t)gw * 1024 + 4 * lane + 256 * j)); } }
    for (int row = gw; row < MTOK; row += NGW) {
        const int nrow = row + NGW;
        if (nrow < MTOK) {
#pragma unroll
            for (int j = 0; j < 4; ++j) { frn[j] = __builtin_nontemporal_load((const u32x2*)(F + (size_t)nrow * 1024 + 4 * lane + 256 * j)); ovn[j] = __builtin_nontemporal_load((const f32x4*)(p.out + (size_t)nrow * 1024 + 4 * lane + 256 * j)); } }
        const int b = row >> 13; const float* md = mod + b * 6144;
        f32x4 f[4]; float ss = 0.f;
#pragma unroll
        for (int j = 0; j < 4; ++j) { f[j] = unpk4(fr_[j]); ss += (f[j][0] * f[j][0] + f[j][1] * f[j][1]) + (f[j][2] * f[j][2] + f[j][3] * f[j][3]); }
        const float rs = rsqrtf(wave_sum(ss) * (1.0f / 1024.0f) + EPS);
#pragma unroll
        for (int j = 0; j < 4; ++j) { const int c = 4 * lane + 256 * j; const f32x4 g = *(const f32x4*)(p.in[17] + c), gt = *(const f32x4*)(md + 5120 + c);
            __builtin_nontemporal_store(ov[j] + gt * ((f[j] * rs) * g), (f32x4*)(p.out + (size_t)row * 1024 + c)); }
#pragma unroll
        for (int j = 0; j < 4; ++j) { fr_[j] = frn[j]; ov[j] = ovn[j]; }
    }
}

constexpr int NPHASE = 15;
template <bool COOP>
__global__ void __launch_bounds__(512, 2) k_main(Params p, int ph_lo, int ph_hi) {
    extern __shared__ __attribute__((aligned(16))) unsigned char shm[];
    LAS unsigned char* lds = (LAS unsigned char*)shm;
    const int blk = blockIdx.x, G = gridDim.x;
    unsigned char* ws = p.ws;
    XcdBarrier xb{};
    if constexpr (COOP) {
        volatile LAS unsigned* st = (volatile LAS unsigned*)(lds + LDS_ST_OFF);
        if (threadIdx.x == 0) { st[0] = 0u; st[1] = 0u; st[2] = 0u; st[3] = 0u; }
        __syncthreads();
        xb = xcd_barrier_post((unsigned*)(ws + OFF_SMALL + SM_BAR), st);
    }
    if constexpr (COOP) { if (ph_hi < 0) cg::this_grid().sync(); }
#define RUNPH(ph, SYNC, ...) if (ph_lo <= (ph) && (ph) < ph_hi) { if constexpr (COOP) { if ((ph) > ph_lo) { if (SYNC == 1) cg::this_grid().sync(); else if (SYNC == 2) xcd_barrier(xb); } } __VA_ARGS__ }
    RUNPH(0, 0, phase0(p, lds, blk, G);)
    RUNPH(1, 2, phase1(p, blk, G);)
    RUNPH(2, 2, { SchedP2 S{G, blk, (const char*)(ws + OFF_H), (const char*)(ws + OFF_WT_IN), (size_t)256 * 1024 * 2};
               EpiP2 E{(bf16_t*)p.out, (bf16_t*)p.out + (size_t)MTOK * 1024, (bf16_t*)(ws + OFF_KT), (bf16_t*)(ws + OFF_VT), (const float*)(ws + OFF_SMALL + SM_COSA), (const float*)(ws + OFF_SMALL + SM_SINA),
                       (const float*)(ws + OFF_SMALL + SM_COSB), (const float*)(ws + OFF_SMALL + SM_SINB)};
               pg8::gemm_phase(lds, 1024, S, E); })
    RUNPH(3, 2, phase3(p, lds, blk, G);)
    RUNPH(4, 2, phase4(p, lds, blk, G, 0, 34);)
    RUNPH(5, 2, phase4(p, lds, blk, G, 34, 66);)
    RUNPH(7, 2, { pg8::Sched1 S{64, 28, G, blk, (const char*)(ws + OFF_H), (const char*)(ws + OFF_WT_IN) + (size_t)R_G * 2048, (size_t)256 * 1024 * 2};
               EpiP6 E{(bf16_t*)(ws + OFF_O), (bf16_t*)(ws + OFF_ARET), (bf16_t*)p.out, (bf16_t*)p.out + (size_t)MTOK * 1024, (bf16_t*)(ws + OFF_GB), p.in[9], p.in[10], (const float*)(ws + OFF_SSQP)};
               pg8::gemm_phase(lds, 1024, S, E); })
    RUNPH(8, 2, { pg8::Sched1 S{64, 4, G, blk, (const char*)(ws + OFF_ARET), (const char*)(ws + OFF_WT_RO), (size_t)256 * 2048 * 2};
               EpiMix<1> E{(bf16_t*)(ws + OFF_T), nullptr, (const bf16_t*)(ws + OFF_GB)}; pg8::gemm_phase(lds, 2048, S, E); })
    if constexpr (COOP) { if (ph_lo <= 9 && 9 < ph_hi && 9 > ph_lo) {
        asm volatile("s_waitcnt vmcnt(0)" ::: "memory"); __syncthreads();
        if (threadIdx.x == 0) { __builtin_amdgcn_fence(__ATOMIC_ACQUIRE, "agent"); asm volatile("s_waitcnt vmcnt(0)" ::: "memory"); }
        __syncthreads(); } }
    RUNPH(9, 0, { pg8::Sched1 S{64, 4, G, blk, (const char*)p.out, (const char*)(ws + OFF_WT_CO), (size_t)256 * 1024 * 2};
               EpiMix<2> E{(bf16_t*)(ws + OFF_MERGED), (const bf16_t*)(ws + OFF_T), (const bf16_t*)p.out + (size_t)MTOK * 1024}; pg8::gemm_phase(lds, 1024, S, E); })
    RUNPH(10, 2, { pg8::Sched1 S{64, 4, G, blk, (const char*)(ws + OFF_MERGED), (const char*)(ws + OFF_WT_O), (size_t)256 * 1024 * 2};
                EpiMix<0> E{(bf16_t*)(ws + OFF_Y), nullptr, nullptr}; pg8::gemm_phase(lds, 1024, S, E); })
    RUNPH(11, 2, phase10(p, blk, G);)
    RUNPH(12, 2, { pg8::Sched1 S{64, 22, G, blk, (const char*)(ws + OFF_H), (const char*)(ws + OFF_WT_UP), (size_t)256 * 1024 * 2};
                EpiP11 E{(bf16_t*)(ws + OFF_AFFN), p.in[19], p.in[20]}; pg8::gemm_phase(lds, 1024, S, E); })
    RUNPH(13, 2, { pg8::Sched1 S{64, 4, G, blk, (const char*)(ws + OFF_AFFN), (const char*)(ws + OFF_WT_DN), (size_t)256 * DFF * 2};
                EpiP12 E{(bf16_t*)(ws + OFF_F)}; pg8::gemm_phase(lds, DFF, S, E); })
    RUNPH(14, 2, phase13(p, blk, G);)
#undef RUNPH
}

extern "C" void kernel_launch(void* const* d_in, const int* in_sizes, int n_in, void* d_out, int out_size, void* d_ws, size_t ws_size, hipStream_t stream) {
    static int grid = 0;
    if (grid == 0) {
        if (n_in != 22 || out_size != MTOK * D || ws_size < WS_END) { fprintf(stderr, "kernel_launch: unexpected shapes (n_in %d out %d ws %zu)\n", n_in, out_size, ws_size); grid = -1; return; }
        int dev = 0, cus = 0, per_cu = 0;
        (void)hipGetDevice(&dev); (void)hipDeviceGetAttribute(&cus, hipDeviceAttributeMultiprocessorCount, dev);
        (void)hipFuncSetAttribute((const void*)k_main<true>, hipFuncAttributeMaxDynamicSharedMemorySize, LDS_BYTES);
        (void)hipFuncSetAttribute((const void*)k_main<false>, hipFuncAttributeMaxDynamicSharedMemorySize, LDS_BYTES);
        if (hipOccupancyMaxActiveBlocksPerMultiprocessor(&per_cu, (const void*)k_main<true>, 512, LDS_BYTES) != hipSuccess || per_cu < 1) { fprintf(stderr, "kernel_launch: occupancy query says %d\n", per_cu); per_cu = 1; }
        (void)hipGetLastError();
        grid = cus * 1;
        if (grid > 256) grid = 256;
    }
    if (grid < 0) return;
    Params p{};
    for (int i = 0; i < 22; ++i) p.in[i] = (const float*)d_in[i];
    p.out = (float*)d_out; p.ws = (unsigned char*)d_ws;
#if N_LAUNCH_MODE == 0
    (void)hipMemsetAsync((unsigned char*)d_ws + OFF_SMALL + SM_BAR, 0, XCD_BAR_WORDS * 4, stream);
    int lo = 0, hi = NPHASE; void* args[] = {&p, &lo, &hi};
    hipError_t e = hipLaunchCooperativeKernel((const void*)k_main<true>, dim3(grid), dim3(512), args, LDS_BYTES, stream);
    if (e != hipSuccess) fprintf(stderr, "cooperative launch failed: %s (grid %d)\n", hipGetErrorString(e), grid);
#else
    for (int ph = 0; ph < NPHASE; ++ph) hipLaunchKernelGGL(k_main<false>, dim3(grid), dim3(512), LDS_BYTES, stream, p, ph, ph + 1);
#endif
}
```

```cpp
#include <hip/hip_runtime.h>
#include <hip/hip_cooperative_groups.h>
#include <cstdio>
#include <cstdint>
namespace cg = cooperative_groups;

#ifndef N_LAUNCH_MODE
#define N_LAUNCH_MODE 0
#endif

#define LAS __attribute__((address_space(3)))
typedef unsigned short bf16_t;
typedef short bf16x8 __attribute__((ext_vector_type(8)));
typedef float f32x4 __attribute__((ext_vector_type(4)));
typedef unsigned u32x4 __attribute__((ext_vector_type(4)));
typedef unsigned u32x2 __attribute__((ext_vector_type(2)));

constexpr int D = 1024, NB = 2, SEQ = 8192, MTOK = NB * SEQ, CTXL = 256, MCTX = NB * CTXL, MALL = MTOK + MCTX;
constexpr int INC = 11264, DFF = 2816, NMOD = 6;
constexpr int S_CX = 0, S_CB = 1024, S_CC = 2048, S_Q = 3072, S_K = 4096, S_V = 5120, S_G = 7168, S_GA = 9216, S_GB = 10240;
constexpr int R_Q = 0, R_K = 1024, R_V = 2048, R_G = 4096, R_C = 6144, R_GB = 10240;
constexpr float EPS = 1e-6f;
constexpr size_t MiB = (size_t)1 << 20;
constexpr size_t OFF_WT_IN = 0, OFF_WT_CO = 22 * MiB, OFF_WT_RO = 24 * MiB, OFF_WT_O = 28 * MiB, OFF_WT_UP = 30 * MiB, OFF_WT_DN = 41 * MiB,
                 OFF_SMALL = 47 * MiB, OFF_SSAVE = 48 * MiB, OFF_H = 56 * MiB, OFF_Q = 89 * MiB, OFF_K = 121 * MiB, OFF_KT = 153 * MiB, OFF_VT = 186 * MiB,
                 OFF_O = 89 * MiB  , OFF_GB = 153 * MiB, OFF_ARET = 185 * MiB, OFF_Y = 89 * MiB, OFF_T = 56 * MiB  , OFF_MERGED = 153 * MiB  , OFF_AFFN = 89 * MiB, OFF_F = 185 * MiB, OFF_SSQP = 252 * MiB, WS_END = 256 * MiB;
constexpr size_t SM_MOD = 0, SM_COSA = 128 * 1024, SM_SINA = 160 * 1024, SM_COSB = 192 * 1024, SM_SINB = 224 * 1024, SM_DEC = 256 * 1024;
constexpr int LDS_ST_OFF = 139264, LDS_BYTES = LDS_ST_OFF + 16;
constexpr size_t SM_BAR = 512 * 1024, SM_SSQ = 640 * 1024;

struct Params { const float* in[22]; float* out; unsigned char* ws; };

typedef float f32x2_t __attribute__((ext_vector_type(2)));
typedef __bf16 bf16x2_t __attribute__((ext_vector_type(2)));
__device__ __forceinline__ unsigned cvt_pk_bf16(float lo, float hi) { const f32x2_t v = {lo, hi}; const bf16x2_t b = __builtin_convertvector(v, bf16x2_t); return __builtin_bit_cast(unsigned, b); }
__device__ __forceinline__ float bf_lo(unsigned w) { return __builtin_bit_cast(float, w << 16); }
__device__ __forceinline__ float bf_hi(unsigned w) { return __builtin_bit_cast(float, w & 0xffff0000u); }
__device__ __forceinline__ u32x2 pk4(f32x4 v) { u32x2 r; r.x = cvt_pk_bf16(v[0], v[1]); r.y = cvt_pk_bf16(v[2], v[3]); return r; }
__device__ __forceinline__ u32x4 pk8(f32x4 a, f32x4 b) { u32x4 r; r.x = cvt_pk_bf16(a[0], a[1]); r.y = cvt_pk_bf16(a[2], a[3]); r.z = cvt_pk_bf16(b[0], b[1]); r.w = cvt_pk_bf16(b[2], b[3]); return r; }
__device__ __forceinline__ f32x4 unpk4(u32x2 w) { return (f32x4){bf_lo(w.x), bf_hi(w.x), bf_lo(w.y), bf_hi(w.y)}; }
__device__ __forceinline__ float sigmoidf_(float x) { return __builtin_amdgcn_rcpf(1.0f + __builtin_amdgcn_exp2f(-1.4426950408889634f * x)); }
__device__ __forceinline__ float siluf_(float x) { return x * __builtin_amdgcn_rcpf(1.0f + __builtin_amdgcn_exp2f(-1.4426950408889634f * x)); }
__device__ __forceinline__ float wave_sum(float v) {
#pragma unroll
    for (int o = 1; o < 64; o <<= 1) v += __shfl_xor(v, o);
    return v;
}
template <int CTRL> __device__ __forceinline__ float dppmov(float oldv, float src) {
    return __builtin_bit_cast(float, __builtin_amdgcn_update_dpp(__builtin_bit_cast(int, oldv), __builtin_bit_cast(int, src), CTRL, 0xF, 0xF, false));
}
__device__ __forceinline__ float up_nb(float prev, float cur) { const float t = dppmov<0x121>(0.f, prev); return dppmov<0x111>(t, cur); }
__device__ __forceinline__ float dn_nb(float next, float cur) { const float t = dppmov<0x12F>(0.f, next); return dppmov<0x101>(t, cur); }


#define XB_TMO      128
#define XB_XCNT(j)  (256  + 64 * (j))
#define XB_XSUB(j)  (1280 + 64 * (j))
#define XB_XGEN(j)  (2304 + 64 * (j))
#define XB_TOP      3328
#define XB_TOPGEN   3392
#define XCD_BAR_WORDS 3456
#define XB_SPIN_CAP (1u << 22)
__device__ __forceinline__ unsigned xb_ld(unsigned* p)              { return __hip_atomic_load(p, __ATOMIC_RELAXED, __HIP_MEMORY_SCOPE_AGENT); }
__device__ __forceinline__ unsigned xb_add(unsigned* p, unsigned v) { return __hip_atomic_fetch_add(p, v, __ATOMIC_RELAXED, __HIP_MEMORY_SCOPE_AGENT); }
__device__ __forceinline__ unsigned xb_xcc_id() { return (unsigned)__builtin_amdgcn_s_getreg((3 << 11) | 20) & 0xFu; }
#define XB_SPIN(cond, bar) do { unsigned _sp = 0; while (cond) { __builtin_amdgcn_s_sleep(1); \
    if ((++_sp & 255u) == 0u) { if (xb_ld(&(bar)[XB_TMO])) break; if (_sp > XB_SPIN_CAP) { atomicAdd(&(bar)[XB_TMO], 1u); break; } } } } while (0)
struct XcdBarrier { unsigned* bar; unsigned x; volatile LAS unsigned* st; };
__device__ __forceinline__ XcdBarrier xcd_barrier_post(unsigned* bar, volatile LAS unsigned* st) {
    XcdBarrier b; b.bar = bar; b.x = xb_xcc_id(); b.st = st;
    if (threadIdx.x == 0) (void)xb_add(&bar[XB_XCNT(b.x)], 1u);
    return b;
}
__device__ __forceinline__ void xcd_barrier_complete(unsigned* bar, unsigned x, unsigned& nloc, unsigned& nx) {
    const unsigned G = gridDim.x * gridDim.y * gridDim.z;
    unsigned sum, cnt, mine, sp = 0u;
    for (;;) {
        sum = 0u; cnt = 0u; mine = 0u;
#pragma unroll
        for (unsigned j = 0; j < 16; ++j) { const unsigned c = xb_ld(&bar[XB_XCNT(j)]); sum += c; cnt += (c > 0u) ? 1u : 0u; mine = (j == x) ? c : mine; }
        if (sum == G) break;
        __builtin_amdgcn_s_sleep(1);
        if ((++sp & 255u) == 0u) { if (xb_ld(&bar[XB_TMO])) break; if (sp > XB_SPIN_CAP) { atomicAdd(&bar[XB_TMO], 1u); break; } }
    }
    nloc = mine > 0u ? mine : 1u; nx = cnt > 0u ? cnt : 1u;
}
__device__ __forceinline__ void xcd_barrier(const XcdBarrier& b) {
    asm volatile("s_waitcnt vmcnt(0)" ::: "memory");
    __syncthreads();
    if (threadIdx.x == 0) {
        unsigned* bar = b.bar;
        __builtin_amdgcn_s_waitcnt(0);
        unsigned nloc = b.st[0], nx = b.st[1];
        if (nloc == 0u) { xcd_barrier_complete(bar, b.x, nloc, nx); b.st[0] = nloc; b.st[1] = nx; }
        const unsigned old = xb_add(&bar[XB_XSUB(b.x)], 1u);
        const unsigned gen = old / nloc;
        if (old + 1u == (gen + 1u) * nloc) {
            __builtin_amdgcn_fence(__ATOMIC_RELEASE, "agent");
            asm volatile("s_waitcnt vmcnt(0)" ::: "memory");
            const unsigned og = xb_add(&bar[XB_TOP], 1u);
            const unsigned tg = og / nx;
            if (og + 1u == (tg + 1u) * nx) xb_add(&bar[XB_TOPGEN], 1u);
            else XB_SPIN(xb_ld(&bar[XB_TOPGEN]) == tg, bar);
            __builtin_amdgcn_fence(__ATOMIC_ACQUIRE, "agent");
            xb_add(&bar[XB_XGEN(b.x)], 1u);
            asm volatile("s_waitcnt vmcnt(0)" ::: "memory");
        } else {
            XB_SPIN(xb_ld(&bar[XB_XGEN(b.x)]) == gen, bar);
            __builtin_amdgcn_fence(__ATOMIC_ACQUIRE, "agent");
            asm volatile("s_waitcnt vmcnt(0)" ::: "memory");
        }
    }
    __syncthreads();
}

namespace pg8 {
constexpr int BM = 256, BK = 64, HALF = 128, HTB = HALF * BK * 2, STAGE_BYTES = 8 * HTB, NXCD = 8, WGM = 8;
__host__ __device__ __forceinline__ int lds_byte(int r, int c) { const int st = (r >> 4) * 2 + (c >> 5), rr = r & 15, cc = c & 31, ob = rr * 64 + cc * 2; return st * 1024 + (ob ^ (((ob >> 9) & 1) << 5)); }
__host__ __device__ __forceinline__ void stage_rc(int b, int& R, int& C) { const int st = b / 1024, sb = b % 1024, swz = sb ^ (((sb >> 9) & 1) << 5); R = (st >> 1) * 16 + swz / 64; C = (st & 1) * 32 + (swz % 64) / 2; }
__host__ __device__ __forceinline__ int perm32(int rho) { const int n = rho >> 4, i = rho & 15; return 8 * (i >> 2) + 4 * n + (i & 3); }
struct Unit { int pm, pn, kind; };
__device__ __forceinline__ void decode_tile(int wgid, int nM, int nN, int& pm, int& pn) {
    const int nwg = nM * nN;
    { const int q = nwg / NXCD, r = nwg % NXCD, xcd = wgid % NXCD, off = wgid / NXCD; wgid = (xcd < r ? xcd * (q + 1) : r * (q + 1) + (xcd - r) * q) + off; }
    const int nig = WGM * nN, gid = wgid / nig, fm = gid * WGM, gsz = (nM - fm) < WGM ? (nM - fm) : WGM;
    pm = fm + ((wgid % nig) % gsz); pn = (wgid % nig) / gsz;
}
struct Sched1 {
    int nM, nN, G, c; const char* A; const char* B; size_t tstep;
    __device__ __forceinline__ bool next(int i, Unit& u) const { const long L = (long)i * G + c; if (L >= (long)nM * nN) return false; decode_tile((int)L, nM, nN, u.pm, u.pn); u.kind = 0; return true; }
    __device__ __forceinline__ const char* baseA(const Unit& u) const { return A + (size_t)u.pm * tstep; }
    __device__ __forceinline__ const char* baseB(const Unit& u) const { return B + (size_t)u.pn * tstep; }
};

template <class Epi, class Sched>
__device__ __forceinline__ void gemm_phase(LAS unsigned char* lds, const int K, const Sched& S, const Epi& E) {
    const int tid = threadIdx.x, wid = __builtin_amdgcn_readfirstlane(tid >> 6), lane = tid & 63, wr = wid >> 2, wc = wid & 3, fr = lane & 15, fq = lane >> 4;
    const int nt = K / BK;
    unsigned voffA[2], voffB[2];
#pragma unroll
    for (int i = 0; i < 2; ++i) { int R, C; stage_rc(tid * 16 + i * 8192, R, C); const int Rb = Epi::PERM ? ((R & ~31) + perm32(R & 31)) : R; voffA[i] = (unsigned)(R * K + C) * 2u; voffB[i] = (unsigned)(Rb * K + C) * 2u; }
    const size_t kstep = (size_t)(BK * 2);
    const size_t hstep = (size_t)HALF * K * 2;
    const unsigned ldsw = (unsigned)wid * 1024u;
    const int aoff = lds_byte(wr * 64 + fr, fq * 8), boff = lds_byte(wc * 32 + fr, fq * 8);
#define PG8_SA(b, h) (((b) * 2 + (h)) * HTB)
#define PG8_SB(b, h) ((4 + (b) * 2 + (h)) * HTB)
#define PG8_STAGE(bufoff, gbase, voff) do { _Pragma("unroll") for (int _i = 0; _i < 2; ++_i) \
        __builtin_amdgcn_global_load_lds((const unsigned*)((const char*)(gbase) + (voff)[_i]), (LAS unsigned*)(lds + (bufoff) + ldsw + _i * 8192), 16, 0, 0); } while (0)
#define PG8_LDA(dst, b, h) do { _Pragma("unroll") for (int m = 0; m < 4; ++m) _Pragma("unroll") for (int k = 0; k < 2; ++k) dst[m][k] = *(const LAS bf16x8*)(lds + PG8_SA(b, h) + aoff + m * 2048 + k * 1024); } while (0)
#define PG8_LDB(dst, b, h) do { _Pragma("unroll") for (int n = 0; n < 2; ++n) _Pragma("unroll") for (int k = 0; k < 2; ++k) dst[n][k] = *(const LAS bf16x8*)(lds + PG8_SB(b, h) + boff + n * 2048 + k * 1024); } while (0)
#define PG8_MMA(ai, bj, At, Bt) do { __builtin_amdgcn_s_setprio(1); _Pragma("unroll") for (int m = 0; m < 4; ++m) _Pragma("unroll") for (int n = 0; n < 2; ++n) _Pragma("unroll") for (int k = 0; k < 2; ++k) \
        acc[ai][bj][m][n] = __builtin_amdgcn_mfma_f32_16x16x32_bf16(Bt[n][k], At[m][k], acc[ai][bj][m][n], 0, 0, 0); __builtin_amdgcn_s_setprio(0); } while (0)
#define PG8_WAIT_V(n) asm volatile("s_waitcnt vmcnt(" #n ")" ::: "memory")
#define PG8_WAIT_L(n) asm volatile("s_waitcnt lgkmcnt(" #n ")" ::: "memory")
#define PG8_BAR __builtin_amdgcn_s_barrier()
#define PG8_SCHED __builtin_amdgcn_sched_barrier(0)
    Unit cur, nxt; int ui = 0;
    if (!S.next(0, cur)) return;
    f32x4 acc[2][2][4][2];
#pragma unroll
    for (int a = 0; a < 2; ++a)
#pragma unroll
        for (int b = 0; b < 2; ++b)
#pragma unroll
            for (int m = 0; m < 4; ++m)
#pragma unroll
                for (int n = 0; n < 2; ++n) acc[a][b][m][n] = (f32x4){0.f, 0.f, 0.f, 0.f};
    bf16x8 At[4][2], B0[2][2], B1[2][2];
    const char* cA = S.baseA(cur); const char* cB = S.baseB(cur);
    PG8_STAGE(PG8_SB(0, 0), cB, voffB); PG8_STAGE(PG8_SB(0, 1), cB + hstep, voffB); PG8_STAGE(PG8_SA(0, 0), cA, voffA); PG8_STAGE(PG8_SA(0, 1), cA + hstep, voffA);
    if (wr == 1) PG8_BAR;
    PG8_WAIT_V(2); PG8_BAR;
    PG8_STAGE(PG8_SB(1, 0), cB + kstep, voffB); PG8_STAGE(PG8_SA(1, 0), cA + kstep, voffA); PG8_STAGE(PG8_SB(1, 1), cB + hstep + kstep, voffB);
    PG8_WAIT_V(6); PG8_BAR;
    for (;;) {
        const bool has_next = S.next(ui + 1, nxt);
        const char* nA = has_next ? S.baseA(nxt) : cA; const char* nB = has_next ? S.baseB(nxt) : cB;
        for (int t = 0; t < nt; t += 2) {
            const bool last = (t == nt - 2);
            const char* a1 = cA + (size_t)(t + 1) * kstep;
            const char* a2 = last ? nA : cA + (size_t)(t + 2) * kstep; const char* b2 = last ? nB : cB + (size_t)(t + 2) * kstep;
            const char* a3 = a2 + kstep; const char* b3 = b2 + kstep;
            PG8_LDB(B0, 0, 0); PG8_LDB(B1, 0, 1); PG8_SCHED; PG8_LDA(At, 0, 0); PG8_STAGE(PG8_SA(1, 1), a1 + hstep, voffA);
            PG8_WAIT_V(8); PG8_WAIT_L(0); PG8_BAR; PG8_MMA(0, 0, At, B0); PG8_MMA(0, 1, At, B1); PG8_BAR; PG8_SCHED;
            PG8_LDA(At, 0, 1); PG8_STAGE(PG8_SB(0, 0), b2, voffB); PG8_STAGE(PG8_SB(0, 1), b2 + hstep, voffB); PG8_STAGE(PG8_SA(0, 0), a2, voffA);
            PG8_WAIT_V(8); PG8_WAIT_L(0); PG8_BAR; PG8_MMA(1, 0, At, B0); PG8_MMA(1, 1, At, B1); PG8_BAR; PG8_SCHED;
            PG8_LDB(B0, 1, 0); PG8_LDB(B1, 1, 1); PG8_SCHED; PG8_LDA(At, 1, 0); PG8_STAGE(PG8_SA(0, 1), a2 + hstep, voffA);
            PG8_WAIT_V(8); PG8_WAIT_L(0); PG8_BAR; PG8_MMA(0, 0, At, B0); PG8_MMA(0, 1, At, B1); PG8_BAR; PG8_SCHED;
            PG8_LDA(At, 1, 1); PG8_STAGE(PG8_SB(1, 0), b3, voffB); PG8_STAGE(PG8_SB(1, 1), b3 + hstep, voffB); PG8_STAGE(PG8_SA(1, 0), a3, voffA);
            PG8_WAIT_V(8); PG8_WAIT_L(0); PG8_BAR; PG8_MMA(1, 0, At, B0); PG8_MMA(1, 1, At, B1); PG8_BAR; PG8_SCHED;
        }
        if (wr == 0) PG8_BAR;
        E(acc, cur, wr, wc, fr, fq);
        if (!has_next) break;
#pragma unroll
        for (int a = 0; a < 2; ++a)
#pragma unroll
            for (int b = 0; b < 2; ++b)
#pragma unroll
                for (int m = 0; m < 4; ++m)
#pragma unroll
                    for (int n = 0; n < 2; ++n) acc[a][b][m][n] = (f32x4){0.f, 0.f, 0.f, 0.f};
        cur = nxt; cA = nA; cB = nB; ++ui;
        if (wr == 1) PG8_BAR;
    }
    PG8_WAIT_V(0);
    PG8_BAR;
#undef PG8_SA
#undef PG8_SB
#undef PG8_STAGE
#undef PG8_LDA
#undef PG8_LDB
#undef PG8_MMA
#undef PG8_WAIT_V
#undef PG8_WAIT_L
#undef PG8_BAR
#undef PG8_SCHED
}
}
using pg8::Unit;
typedef f32x4 Acc[2][2][4][2];

__device__ __forceinline__ unsigned qf_idx(int tok, int h, int dkl) { const unsigned frag = ((unsigned)(tok >> 4) * 4 + h) * 8 + (dkl >> 5); return (frag * 64 + ((dkl >> 3) & 3) * 16 + (tok & 15)) * 8 + (dkl & 7); }
__device__ __forceinline__ unsigned ktf_idx(int r, int tau) { const int tl = tau & 127; const unsigned frag = (((unsigned)(tau >> 7) * 4 + (r >> 8)) * 16 + ((r & 255) >> 4)) * 4 + (tl >> 5); return (frag * 64 + ((tl >> 3) & 3) * 16 + (r & 15)) * 8 + (tl & 7); }
struct SchedP2 {
    int G, c; const char* H; const char* W; size_t tstep;
    __device__ __forceinline__ bool next(int i, Unit& u) const {
        const long L = (long)i * G + c; if (L >= 1280) return false;
        if (L < 512) { u.kind = 0; pg8::decode_tile((int)L, 64, 8, u.pm, u.pn); } else { u.kind = 1; pg8::decode_tile((int)L - 512, 12, 64, u.pm, u.pn); }
        return true;
    }
    __device__ __forceinline__ const char* baseA(const Unit& u) const { return u.kind == 0 ? H + (size_t)u.pm * tstep : W + (size_t)(R_K / 256 + u.pm) * tstep; }
    __device__ __forceinline__ const char* baseB(const Unit& u) const { return u.kind == 0 ? W + (size_t)u.pn * tstep : H + (size_t)u.pn * tstep; }
};
struct EpiP2 {
    static constexpr bool PERM = true;
    bf16_t *Q, *Kk, *KT, *VT; const float *cosA, *sinA, *cosB, *sinB;
    __device__ __forceinline__ void operator()(const Acc& acc, const Unit& u, int wr, int wc, int fr, int fq) const {
        if (u.kind == 0) {
            const int head = u.pn & 3; const bool isK = u.pn >= 4; const float sc = isK ? 0.0625f : 1.0f;
            bf16_t* qbase = Q + ((((unsigned)((u.pm * 16 + wr * 4) * 4 + head) * 8 + wc) * 64 + fq * 16 + fr) * 8);
#pragma unroll
            for (int ai = 0; ai < 2; ++ai)
#pragma unroll
                for (int m = 0; m < 4; ++m) {
                    const int tok = u.pm * 256 + ai * 128 + wr * 64 + m * 16 + fr;
                    const int pos = (wc < 2) ? ((tok & (SEQ - 1)) >> 6) : (tok & 63);
                    f32x4 o1[2], o2[2];
#pragma unroll
                    for (int n = 0; n < 2; ++n) {
                        const int i0 = wc * 32 + fq * 8 + n * 4;
                        const f32x4 cs = *(const f32x4*)(cosA + pos * 64 + (i0 & 63)), sn = *(const f32x4*)(sinA + pos * 64 + (i0 & 63));
                        const f32x4 t1 = acc[ai][0][m][n], t2 = acc[ai][1][m][n];
                        o1[n] = (t1 * cs - t2 * sn) * sc; o2[n] = (t2 * cs + t1 * sn) * sc;
                    }
                    if (isK) { bf16_t* rp = Kk + (size_t)tok * 1024 + head * 256 + wc * 32 + fq * 8; *(u32x4*)rp = pk8(o1[0], o1[1]); *(u32x4*)(rp + 128) = pk8(o2[0], o2[1]); }
                    else { bf16_t* rp = qbase + (ai * 8 + m) * 16384; *(u32x4*)rp = pk8(o1[0], o1[1]); *(u32x4*)(rp + 2048) = pk8(o2[0], o2[1]); }
                }
        } else if (u.pm < 4) {
            bf16_t* ktbase = KT + (((((unsigned)((u.pn * 2) * 4 + u.pm) * 16 + wr * 4) * 4 + wc) * 64 + fq * 16 + fr) * 8);
#pragma unroll
            for (int m = 0; m < 4; ++m) {
                const int d = wr * 64 + m * 16 + fr;
#pragma unroll
                for (int bj = 0; bj < 2; ++bj) {
                    f32x4 o1[2], o2[2];
#pragma unroll
                    for (int n = 0; n < 2; ++n) {
                        const int tau = u.pn * 256 + bj * 128 + wc * 32 + fq * 8 + n * 4;
                        f32x4 cs, sn;
                        if (wr == 0) { const int pos = (tau & (SEQ - 1)) >> 6; const float c1 = cosA[pos * 64 + d], s1 = sinA[pos * 64 + d]; cs = (f32x4){c1, c1, c1, c1}; sn = (f32x4){s1, s1, s1, s1}; }
                        else { const int pos = tau & 63; cs = *(const f32x4*)(cosB + (d & 63) * 128 + pos); sn = *(const f32x4*)(sinB + (d & 63) * 128 + pos); }
                        const f32x4 t1 = acc[0][bj][m][n], t2 = acc[1][bj][m][n];
                        o1[n] = (t1 * cs - t2 * sn) * 0.0625f; o2[n] = (t2 * cs + t1 * sn) * 0.0625f;
                    }
                    bf16_t* rp = ktbase + bj * 131072 + m * 2048; *(u32x4*)rp = pk8(o1[0], o1[1]); *(u32x4*)(rp + 16384) = pk8(o2[0], o2[1]);
                }
            }
        } else {
#pragma unroll
            for (int ai = 0; ai < 2; ++ai)
#pragma unroll
                for (int m = 0; m < 4; ++m) {
                    bf16_t* rp = VT + (size_t)((u.pm - 4) * 256 + ai * 128 + wr * 64 + m * 16 + fr) * MALL + u.pn * 256 + wc * 32 + fq * 8;
#pragma unroll
                    for (int bj = 0; bj < 2; ++bj) *(u32x4*)(rp + bj * 128) = pk8(acc[ai][bj][m][0], acc[ai][bj][m][1]);
                }
        }
    }
};

struct EpiP6 {
    static constexpr bool PERM = true;
    bf16_t *O, *ARET, *ACONV, *GA, *GB; const float *cw, *cb, *ssq;
    __device__ __forceinline__ void operator()(const Acc& acc, const Unit& u, int wr, int wc, int fr, int fq) const {
        if (u.pn < 8) {
#pragma unroll
            for (int ai = 0; ai < 2; ++ai)
#pragma unroll
                for (int m = 0; m < 4; ++m) {
                    const int tokr = u.pm * 256 + ai * 128 + wr * 64 + m * 16 + fr;
                    const size_t off = (size_t)tokr * 2048 + u.pn * 256 + wc * 32 + fq * 8;
                    const f32x4* sp = (const f32x4*)(ssq + ((size_t)tokr * 4 + (u.pn >> 1)) * 16);
                    const f32x4 s0 = sp[0], s1 = sp[1], s2 = sp[2], s3 = sp[3];
                    const float ssum = (((s0[0] + s0[1]) + (s0[2] + s0[3])) + ((s1[0] + s1[1]) + (s1[2] + s1[3]))) + (((s2[0] + s2[1]) + (s2[2] + s2[3])) + ((s3[0] + s3[1]) + (s3[2] + s3[3])));
                    const float rstd = rsqrtf(ssum * (1.0f / 512.0f) + EPS);
#pragma unroll
                    for (int bj = 0; bj < 2; ++bj) {
                        const u32x4 ov = __builtin_nontemporal_load((const u32x4*)(O + ((((size_t)(u.pm * 2 + ai) * 4 + (u.pn >> 1)) * 16 + (u.pn & 1) * 8 + bj * 4 + wc) * 8 + wr * 4 + m) * 512 + (fq * 16 + fr) * 8));
                        const f32x4 o0 = unpk4((u32x2){ov.x, ov.y}), o1 = unpk4((u32x2){ov.z, ov.w}); const f32x4 g0 = acc[ai][bj][m][0], g1 = acc[ai][bj][m][1];
                        f32x4 r0, r1;
#pragma unroll
                        for (int j = 0; j < 4; ++j) { r0[j] = siluf_(g0[j]) * (o0[j] * rstd); r1[j] = siluf_(g1[j]) * (o1[j] * rstd); }
                        *(u32x4*)(ARET + off + bj * 128) = pk8(r0, r1);
                    }
                }
        } else if (u.pn < 24) {
            const int ch0 = (u.pn - 8) * 64 + wc * 16 + fq * 4;
            const f32x4 w0 = *(const f32x4*)(cw + ch0), w1 = *(const f32x4*)(cw + 1024 + ch0), w2 = *(const f32x4*)(cw + 2048 + ch0), bb = *(const f32x4*)(cb + ch0);
#pragma unroll
            for (int ai = 0; ai < 2; ++ai) {
                f32x4 uu[4];
#pragma unroll
                for (int m = 0; m < 4; ++m) uu[m] = acc[ai][0][m][0] * acc[ai][0][m][1];
#pragma unroll
                for (int m = 0; m < 4; ++m) {
                    f32x4 r, sg;
#pragma unroll
                    for (int j = 0; j < 4; ++j) {
                        const float up = up_nb(m > 0 ? uu[m - 1][j] : 0.f, uu[m][j]);
                        const float dn = dn_nb(m < 3 ? uu[m + 1][j] : 0.f, uu[m][j]);
                        r[j] = acc[ai][1][m][0][j] * (w0[j] * up + w1[j] * uu[m][j] + w2[j] * dn + bb[j]);
                        sg[j] = sigmoidf_(acc[ai][1][m][1][j]);
                    }
                    const size_t off = (size_t)(u.pm * 256 + ai * 128 + wr * 64 + m * 16 + fr) * 1024 + ch0;
                    *(u32x2*)(ACONV + off) = pk4(r); *(u32x2*)(GA + off) = pk4(sg);
                }
            }
        } else {
#pragma unroll
            for (int ai = 0; ai < 2; ++ai)
#pragma unroll
                for (int m = 0; m < 4; ++m) {
                    bf16_t* rp = GB + (size_t)(u.pm * 256 + ai * 128 + wr * 64 + m * 16 + fr) * 1024 + (u.pn - 24) * 256 + wc * 32 + fq * 8;
#pragma unroll
                    for (int bj = 0; bj < 2; ++bj) { const f32x4 g0 = acc[ai][bj][m][0], g1 = acc[ai][bj][m][1]; f32x4 r0, r1;
#pragma unroll
                        for (int j = 0; j < 4; ++j) { r0[j] = sigmoidf_(g0[j]); r1[j] = sigmoidf_(g1[j]); }
                        *(u32x4*)(rp + bj * 128) = pk8(r0, r1); }
                }
        }
    }
};
template <int MODE> struct EpiMix {
    static constexpr bool PERM = true;
    bf16_t* dst; const bf16_t* add; const bf16_t* mul;
    __device__ __forceinline__ void operator()(const Acc& acc, const Unit& u, int wr, int wc, int fr, int fq) const {
#pragma unroll
        for (int ai = 0; ai < 2; ++ai)
#pragma unroll
            for (int m = 0; m < 4; ++m) {
                const size_t off = (size_t)(u.pm * 256 + ai * 128 + wr * 64 + m * 16 + fr) * 1024 + u.pn * 256 + wc * 32 + fq * 8;
#pragma unroll
                for (int bj = 0; bj < 2; ++bj) {
                    const size_t o2 = off + bj * 128; f32x4 r0 = acc[ai][bj][m][0], r1 = acc[ai][bj][m][1];
                    if (MODE >= 1) { const u32x4 d = __builtin_nontemporal_load((const u32x4*)(mul + o2)); r0 = r0 * unpk4((u32x2){d.x, d.y}); r1 = r1 * unpk4((u32x2){d.z, d.w}); }
                    if (MODE == 2) { const u32x4 a = __builtin_nontemporal_load((const u32x4*)(add + o2)); r0 = r0 + unpk4((u32x2){a.x, a.y}); r1 = r1 + unpk4((u32x2){a.z, a.w}); }
                    *(u32x4*)(dst + o2) = pk8(r0, r1);
                }
            }
    }
};
struct EpiP11 {
    static constexpr bool PERM = true;
    bf16_t* AF; const float *cw, *cb;
    __device__ __forceinline__ void operator()(const Acc& acc, const Unit& u, int wr, int wc, int fr, int fq) const {
        u32x2 keep[8];
#pragma unroll
        for (int n = 0; n < 2; ++n) {
            const int ch0 = u.pn * 128 + wc * 32 + fq * 8 + n * 4;
            const f32x4 g0 = *(const f32x4*)(cw + ch0), g1 = *(const f32x4*)(cw + 2 * DFF + ch0), g2 = *(const f32x4*)(cw + 4 * DFF + ch0), gb = *(const f32x4*)(cb + ch0);
            const f32x4 v0 = *(const f32x4*)(cw + DFF + ch0), v1 = *(const f32x4*)(cw + 3 * DFF + ch0), v2 = *(const f32x4*)(cw + 5 * DFF + ch0), vb = *(const f32x4*)(cb + DFF + ch0);
#pragma unroll
            for (int s = 0; s < 8; ++s) {
                f32x4 r;
#pragma unroll
                for (int j = 0; j < 4; ++j) {
                    const float cg_ = acc[s >> 2][0][s & 3][n][j], cv_ = acc[s >> 2][1][s & 3][n][j];
                    const float ugp = up_nb(s > 0 ? acc[(s - 1) >> 2][0][(s - 1) & 3][n][j] : 0.f, cg_);
                    const float ugn = dn_nb(s < 7 ? acc[(s + 1) >> 2][0][(s + 1) & 3][n][j] : 0.f, cg_);
                    const float uvp = up_nb(s > 0 ? acc[(s - 1) >> 2][1][(s - 1) & 3][n][j] : 0.f, cv_);
                    const float uvn = dn_nb(s < 7 ? acc[(s + 1) >> 2][1][(s + 1) & 3][n][j] : 0.f, cv_);
                    const float ug = g0[j] * ugp + g1[j] * cg_ + g2[j] * ugn + gb[j];
                    const float uv = v0[j] * uvp + v1[j] * cv_ + v2[j] * uvn + vb[j];
                    r[j] = siluf_(ug) * uv;
                }
                if (n == 0) keep[s] = pk4(r);
                else { const u32x2 hi = pk4(r); u32x4 o; o.x = keep[s].x; o.y = keep[s].y; o.z = hi.x; o.w = hi.y;
                    *(u32x4*)(AF + (size_t)(u.pm * 256 + (s >> 2) * 128 + wr * 64 + (s & 3) * 16 + fr) * DFF + u.pn * 128 + wc * 32 + fq * 8) = o; }
            }
        }
    }
};
struct EpiP12 {
    static constexpr bool PERM = true;
    bf16_t* F;
    __device__ __forceinline__ void operator()(const Acc& acc, const Unit& u, int wr, int wc, int fr, int fq) const {
        const int b = u.pm >> 5, gc = (u.pm & 31) * 2 + wr;
#pragma unroll
        for (int ai = 0; ai < 2; ++ai)
#pragma unroll
            for (int m = 0; m < 4; ++m) {
                const int tok = b * SEQ + (ai * 64 + m * 16 + fr) * 64 + gc;
                bf16_t* rp = F + (size_t)tok * 1024 + u.pn * 256 + wc * 32 + fq * 8;
#pragma unroll
                for (int bj = 0; bj < 2; ++bj) *(u32x4*)(rp + bj * 128) = pk8(acc[ai][bj][m][0], acc[ai][bj][m][1]);
            }
    }
};

struct RowMapId { int off; __device__ __forceinline__ int operator()(int n) const { return off + n; } };
struct RowMapIn {
    __device__ __forceinline__ int operator()(int n) const {
        int s, ch;
        if (n < S_Q) { if (n < S_CB) { s = 0; ch = n; } else if (n < S_CC) { s = 2; ch = n - S_CB; } else { s = 1; ch = n - S_CC; } }
        else if (n < S_K) return R_Q + (n - S_Q);
        else if (n < S_V) return R_K + (n - S_K);
        else if (n < S_G) return R_V + (n - S_V);
        else if (n < S_GA) return R_G + (n - S_G);
        else if (n < S_GB) { s = 3; ch = n - S_GA; }
        else return R_GB + (n - S_GB);
        const int cl = ch & 63;
        return R_C + 256 * (ch >> 6) + 128 * (s >> 1) + 32 * (cl >> 4) + 8 * ((cl >> 2) & 3) + 4 * (s & 1) + (cl & 3);
    }
};
struct RowMapUp { __device__ __forceinline__ int operator()(int n) const { const int v = n >= DFF, ch = v ? n - DFF : n; return 256 * (ch >> 7) + 128 * v + (ch & 127); } };

template <class RowMap>
__device__ __forceinline__ void transpose_item(const float* W, int K, int N, bf16_t* WT, const RowMap rm, LAS float* scr, int item, int lane) {
    const int nblk = N / 32, kb = item / nblk, nb = item % nblk, k0 = 64 * kb, n0 = 32 * nb;
    float tv[32];
#pragma unroll
    for (int i = 0; i < 32; ++i) tv[i] = __builtin_nontemporal_load(W + (size_t)(k0 + 2 * i + (lane >> 5)) * N + n0 + (lane & 31));
#pragma unroll
    for (int i = 0; i < 32; ++i) scr[(2 * i + (lane >> 5)) * 33 + (lane & 31)] = tv[i];
    asm volatile("s_waitcnt lgkmcnt(0)" ::: "memory");
    const int c = lane & 7;
#pragma unroll
    for (int j = 0; j < 4; ++j) { const int n = (lane >> 3) + 8 * j; const LAS float* s = scr + (8 * c) * 33 + n;
        u32x4 o; o.x = cvt_pk_bf16(s[0 * 33], s[1 * 33]); o.y = cvt_pk_bf16(s[2 * 33], s[3 * 33]); o.z = cvt_pk_bf16(s[4 * 33], s[5 * 33]); o.w = cvt_pk_bf16(s[6 * 33], s[7 * 33]);
        *(u32x4*)(WT + (size_t)rm(n0 + n) * K + k0 + 8 * c) = o; }
    asm volatile("s_waitcnt lgkmcnt(0)" ::: "memory");
}

__device__ __forceinline__ void phase0(const Params& p, LAS unsigned char* lds, int blk, int G) {
    const int tid = threadIdx.x, lane = tid & 63, wave = tid >> 6;
    float* small = (float*)(p.ws + OFF_SMALL);
    for (int i = blk * 512 + tid; i < 8192; i += G * 512) {
        const int pos = i >> 6, f = i & 63; const float inv = powf(10000.0f, -(float)f / 64.0f), ang = (float)pos * inv; const float cs = cosf(ang), sn = sinf(ang);
        ((float*)(p.ws + OFF_SMALL + SM_COSA))[pos * 64 + f] = cs; ((float*)(p.ws + OFF_SMALL + SM_SINA))[pos * 64 + f] = sn;
        ((float*)(p.ws + OFF_SMALL + SM_COSB))[f * 128 + pos] = cs; ((float*)(p.ws + OFF_SMALL + SM_SINB))[f * 128 + pos] = sn;
    }
    if (blk == 0 && tid < 8) {
        const float th = (tid < 4) ? p.in[12][tid] : p.in[13][tid - 4];
        const float lg = -(th > 0.f ? log1pf(expf(-th)) : (-th + log1pf(expf(th))));
        ((float*)(p.ws + OFF_SMALL + SM_DEC))[tid] = lg * 1.4426950408889634f;
    }
    if (blk < 96) {
        LAS float* sv = (LAS float*)lds; LAS float* red = sv + 3 * 1024;
        for (int i = tid; i < 3 * 1024; i += 512) { const int v = i >> 10, k = i & 1023; const float cv = (v < 2) ? p.in[1][v * 1024 + k] : p.in[3][k]; sv[i] = siluf_(cv); }
        __syncthreads();
        for (int item = blk; item < 96; item += G) {
            const int kg = tid >> 6, col = item * 64 + (tid & 63); const float* wp = p.in[4] + (size_t)(kg * 128) * 6144 + col;
            float a0 = 0.f, a1 = 0.f, a2 = 0.f;
#pragma unroll 32
            for (int k = 0; k < 128; ++k) { const float w = __builtin_nontemporal_load(wp + (size_t)k * 6144); a0 += sv[kg * 128 + k] * w; a1 += sv[1024 + kg * 128 + k] * w; a2 += sv[2048 + kg * 128 + k] * w; }
            red[(kg * 64 + (tid & 63)) * 3 + 0] = a0; red[(kg * 64 + (tid & 63)) * 3 + 1] = a1; red[(kg * 64 + (tid & 63)) * 3 + 2] = a2;
            __syncthreads();
            if (tid < 192) { const int v = tid >> 6, cl = tid & 63; float s = p.in[5][item * 64 + cl];
#pragma unroll
                for (int g = 0; g < 8; ++g) s += red[(g * 64 + cl) * 3 + v];
                small[SM_MOD / 4 + v * 6144 + item * 64 + cl] = s; }
            __syncthreads();
        }
    }
    LAS float* scr = (LAS float*)(lds + wave * 8704);
    const int gw = blk * 8 + wave, NGW = G * 8;
    constexpr int I_IN = 16 * (INC / 32), I_CO = 16 * 32, I_RO = 32 * 32, I_O = 16 * 32, I_UP = 16 * (2 * DFF / 32), I_DN = (DFF / 64) * 32;
    constexpr int NITEMS = I_IN + I_CO + I_RO + I_O + I_UP + I_DN;
    for (int it = gw; it < NITEMS; it += NGW) {
        int r = it;
        if (r < I_IN) { transpose_item(p.in[8], 1024, INC, (bf16_t*)(p.ws + OFF_WT_IN), RowMapIn{}, scr, r, lane); continue; } r -= I_IN;
        if (r < I_CO) { transpose_item(p.in[11], 1024, 1024, (bf16_t*)(p.ws + OFF_WT_CO), RowMapId{0}, scr, r, lane); continue; } r -= I_CO;
        if (r < I_RO) { transpose_item(p.in[14], 2048, 1024, (bf16_t*)(p.ws + OFF_WT_RO), RowMapId{0}, scr, r, lane); continue; } r -= I_RO;
        if (r < I_O) { transpose_item(p.in[15], 1024, 1024, (bf16_t*)(p.ws + OFF_WT_O), RowMapId{0}, scr, r, lane); continue; } r -= I_O;
        if (r < I_UP) { transpose_item(p.in[18], 1024, 2 * DFF, (bf16_t*)(p.ws + OFF_WT_UP), RowMapUp{}, scr, r, lane); continue; } r -= I_UP;
        transpose_item(p.in[21], DFF, 1024, (bf16_t*)(p.ws + OFF_WT_DN), RowMapId{0}, scr, r, lane);
    }
}

__device__ __forceinline__ void phase1(const Params& p, int blk, int G) {
    const int lane = threadIdx.x & 63, gw = blk * 8 + (threadIdx.x >> 6), NGW = G * 8;
    const float* mod = (const float*)(p.ws + OFF_SMALL + SM_MOD); bf16_t* H = (bf16_t*)(p.ws + OFF_H);
    auto rowsrc = [&](int row) { return row < MTOK ? p.in[0] + (size_t)row * 1024 : p.in[2] + (size_t)(row - MTOK) * 1024; };
    f32x4 x[4], xn[4];
    if (gw < MALL) { const float* s = rowsrc(gw);
#pragma unroll
        for (int j = 0; j < 4; ++j) x[j] = __builtin_nontemporal_load((const f32x4*)(s + 4 * lane + 256 * j)); }
    for (int row = gw; row < MALL; row += NGW) {
        const int nrow = row + NGW;
        if (nrow < MALL) { const float* s = rowsrc(nrow);
#pragma unroll
            for (int j = 0; j < 4; ++j) xn[j] = __builtin_nontemporal_load((const f32x4*)(s + 4 * lane + 256 * j)); }
        const int v = row < MTOK ? (row >> 13) : 2; const float* sh = mod + v * 6144; const float* scl = sh + 1024;
        float ss = 0.f;
#pragma unroll
        for (int j = 0; j < 4; ++j) ss += (x[j][0] * x[j][0] + x[j][1] * x[j][1]) + (x[j][2] * x[j][2] + x[j][3] * x[j][3]);
        const float rs = rsqrtf(wave_sum(ss) * (1.0f / 1024.0f) + EPS);
#pragma unroll
        for (int j = 0; j < 4; ++j) { const int c = 4 * lane + 256 * j; const f32x4 g = *(const f32x4*)(p.in[6] + c), s1 = *(const f32x4*)(scl + c), s0 = *(const f32x4*)(sh + c);
            const f32x4 r = (x[j] * rs) * g * (s1 + 1.0f) + s0; *(u32x2*)(H + (size_t)row * 1024 + c) = pk4(r); }
#pragma unroll
        for (int j = 0; j < 4; ++j) x[j] = xn[j];
    }
}

#define LDS_BARRIER() do { asm volatile("s_waitcnt lgkmcnt(0)" ::: "memory"); __builtin_amdgcn_s_barrier(); asm volatile("" ::: "memory"); } while (0)
#define MFMA16(a, b, c) __builtin_amdgcn_mfma_f32_16x16x32_bf16((a), (b), (c), 0, 0, 0)
__device__ __forceinline__ void phase3(const Params& p, LAS unsigned char* lds, int blk, int G) {
    const int tid = threadIdx.x, lane = tid & 63, w = tid >> 6, fr = lane & 15, fq = lane >> 4;
    const bf16_t* Q = (const bf16_t*)p.out; const bf16_t* Kk = (const bf16_t*)p.out + (size_t)MTOK * 1024; const bf16_t* VT = (const bf16_t*)(p.ws + OFF_VT);
    bf16_t* O = (bf16_t*)(p.ws + OFF_O); const float* dec = (const float*)(p.ws + OFF_SMALL + SM_DEC);
    LAS bf16_t* Kl = (LAS bf16_t*)lds;
    LAS bf16_t* Vl = (LAS bf16_t*)(lds + 67584);
    LAS bf16_t* Pl = (LAS bf16_t*)(lds + w * 4352);
    {
        const bf16_t* Hc = (const bf16_t*)(p.ws + OFF_H) + (size_t)MTOK * 1024; const bf16_t* Wkv = (const bf16_t*)(p.ws + OFF_WT_IN) + (size_t)R_K * 1024;
        bf16_t* KTo = (bf16_t*)(p.ws + OFF_KT); bf16_t* VTo = (bf16_t*)(p.ws + OFF_VT);
        for (int t = blk * 8 + w; t < 96 * 16; t += G * 8) {
            const int row0 = (t >> 4) * 32, tok0 = (t & 15) * 32;
            f32x4 a[2][2];
#pragma unroll
            for (int i = 0; i < 2; ++i)
#pragma unroll
                for (int j = 0; j < 2; ++j) a[i][j] = (f32x4){0.f, 0.f, 0.f, 0.f};
            const bf16_t* hp = Hc + (size_t)(tok0 + fr) * 1024 + 8 * fq; const bf16_t* wp = Wkv + (size_t)(row0 + fr) * 1024 + 8 * fq;
#pragma unroll 8
            for (int ks = 0; ks < 32; ++ks) {
                const bf16x8 h0 = *(const bf16x8*)(hp + 32 * ks), h1 = *(const bf16x8*)(hp + 16 * 1024 + 32 * ks);
                const bf16x8 w0 = *(const bf16x8*)(wp + 32 * ks), w1 = *(const bf16x8*)(wp + 16 * 1024 + 32 * ks);
                a[0][0] = MFMA16(h0, w0, a[0][0]); a[0][1] = MFMA16(h1, w0, a[0][1]); a[1][0] = MFMA16(h0, w1, a[1][0]); a[1][1] = MFMA16(h1, w1, a[1][1]);
            }
#pragma unroll
            for (int i = 0; i < 2; ++i)
#pragma unroll
                for (int j = 0; j < 2; ++j) {
                    const int row = row0 + 16 * i + fr, tau = MTOK + tok0 + 16 * j + 4 * fq;
                    if (row < 1024) *(u32x2*)(KTo + ktf_idx(row, tau)) = pk4(a[i][j] * 0.0625f);
                    else *(u32x2*)(VTo + (size_t)(row - 1024) * MALL + tau) = pk4(a[i][j]);
                }
        }
    }
    for (int it = 0; it < (G == 256 ? 2 : (512 + G - 1) / G); ++it) {
        const int item = (G == 256) ? ((blk & 7) * 64 + (blk >> 3) + 32 * it) : (blk + it * G);
        if (item >= 512) break;
        const int c = item & 63, h = (item >> 6) & 3, b = item >> 8; const int t0 = b * SEQ + c * 128;
        const float lf = dec[h], lb = dec[4 + h];
        const float di = (float)(16 * w + fr - 4 * fq);
#pragma unroll
        for (int i = 0; i < 8; ++i) { const int idx = tid + 512 * i, row = idx >> 5, pc = idx & 31;
            *(LAS u32x4*)(Kl + row * 264 + pc * 8) = __builtin_nontemporal_load((const u32x4*)(Kk + (size_t)(t0 + row) * 1024 + h * 256 + pc * 8)); }
#pragma unroll
        for (int i = 0; i < 8; ++i) { const int idx = tid + 512 * i, row = idx >> 4, pc = idx & 15;
            *(LAS u32x4*)(Vl + row * 136 + pc * 8) = *(const u32x4*)(VT + (size_t)(h * 512 + (row & ~31) + 8 * ((row >> 2) & 3) + 4 * ((row >> 4) & 1) + (row & 3)) * MALL + t0 + pc * 8); }
        bf16x8 qf[8];
#pragma unroll
        for (int ks = 0; ks < 8; ++ks) qf[ks] = *(const bf16x8*)(Q + ((((size_t)((t0 >> 4) + w) * 4 + h) * 8 + ks) * 64 + lane) * 8);
        LDS_BARRIER();
        u32x4 vnext[8];
#pragma unroll
        for (int i = 0; i < 8; ++i) { const int idx = tid + 512 * i, row = idx >> 4, pc = idx & 15;
            vnext[i] = *(const u32x4*)(VT + (size_t)(h * 512 + 256 + (row & ~31) + 8 * ((row >> 2) & 3) + 4 * ((row >> 4) & 1) + (row & 3)) * MALL + t0 + pc * 8); }
        u32x2 pr[8];
#pragma unroll
        for (int nt = 0; nt < 8; ++nt) {
            f32x4 a = (f32x4){0.f, 0.f, 0.f, 0.f};
#pragma unroll
            for (int ks = 0; ks < 8; ++ks) { const bf16x8 kf = *(const LAS bf16x8*)(Kl + (16 * nt + fr) * 264 + 32 * ks + 8 * fq); a = MFMA16(kf, qf[ks], a); }
            f32x4 r;
#pragma unroll
            for (int e = 0; e < 4; ++e) { const float dd = di - (float)(16 * nt + e); const float dm = __builtin_amdgcn_exp2f(dd >= 0.f ? lf * dd : -lb * dd); r[e] = a[e] * dm; }
            pr[nt] = pk4(r);
        }
        LDS_BARRIER();
#pragma unroll
        for (int nt = 0; nt < 8; ++nt) *(LAS u32x2*)(Pl + fr * 136 + 16 * nt + 4 * fq) = pr[nt];
        asm volatile("s_waitcnt lgkmcnt(0)" ::: "memory");
        bf16x8 pf[4];
#pragma unroll
        for (int ks = 0; ks < 4; ++ks) pf[ks] = *(const LAS bf16x8*)(Pl + fr * 136 + 32 * ks + 8 * fq);
#pragma unroll 1
        for (int half = 0; half < 2; ++half) {
            if (half == 1) {
                LDS_BARRIER();
#pragma unroll
                for (int i = 0; i < 8; ++i) { const int idx = tid + 512 * i, row = idx >> 4, pc = idx & 15; *(LAS u32x4*)(Vl + row * 136 + pc * 8) = vnext[i]; }
                LDS_BARRIER();
            }
            f32x4 oa[16];
#pragma unroll
            for (int nt = 0; nt < 16; ++nt) oa[nt] = (f32x4){0.f, 0.f, 0.f, 0.f};
#pragma unroll
            for (int ks = 0; ks < 4; ++ks)
#pragma unroll
                for (int nt = 0; nt < 16; ++nt) { const bf16x8 vf = *(const LAS bf16x8*)(Vl + (16 * nt + fr) * 136 + 32 * ks + 8 * fq); oa[nt] = MFMA16(vf, pf[ks], oa[nt]); }
            bf16_t* rp = O + (((((size_t)(t0 >> 7) * 4 + h) * 16 + half * 8) * 8 + w) * 512) + lane * 8;
#pragma unroll
            for (int g = 0; g < 8; ++g) *(u32x4*)(rp + (size_t)g * 8 * 512) = pk8(oa[2 * g], oa[2 * g + 1]);
        }
        LDS_BARRIER();
    }
}

__device__ __forceinline__ int p4_col0(int s, int b, int dir) { return s < 2 ? MTOK + b * CTXL + (dir == 0 ? s : 1 - s) * 128 : b * SEQ + (dir == 0 ? s - 2 : 65 - s) * 128; }
__device__ __forceinline__ void phase4(const Params& p, LAS unsigned char* lds, int blk, int G, int s_lo, int s_hi) {
    const int tid = threadIdx.x, lane = tid & 63, w = tid >> 6, fr = lane & 15, fq = lane >> 4;
    const bf16_t* Q = (const bf16_t*)p.out; const bf16_t* KT = (const bf16_t*)(p.ws + OFF_KT); const bf16_t* VT = (const bf16_t*)(p.ws + OFF_VT);
    bf16_t* O = (bf16_t*)(p.ws + OFF_O); const float* dec = (const float*)(p.ws + OFF_SMALL + SM_DEC); float* ssave = (float*)(p.ws + OFF_SSAVE);
    float* ssq = (float*)(p.ws + OFF_SSQP);
    LAS bf16_t* Sb = (LAS bf16_t*)lds;
    LAS bf16_t* Vz = (LAS bf16_t*)(lds + 33792);
    for (int item = blk; item < 256; item += G) {
        const int xcd = item & 7, y = item >> 3, chain = xcd * 2 + (y & 1), slice = y >> 1;
        const int dir = chain & 1, h = (chain >> 1) & 3, b = chain >> 3;
        const float lg = dec[dir * 4 + h];
        const float dec128 = exp2f(lg * 128.0f);
        const int irow = 16 * w + fr; const float xi = exp2f(lg * (float)(dir == 0 ? irow + 1 : 128 - irow));
        const int vrow = tid >> 4, vpc = tid & 15;
        float zv[8];
#pragma unroll
        for (int e = 0; e < 8; ++e) { const int j = 8 * vpc + e; zv[e] = exp2f(lg * (float)(dir == 0 ? 127 - j : j)); }
        const bf16_t* vsrc = VT + (size_t)(h * 512 + slice * 32 + 8 * ((vrow >> 2) & 3) + 4 * (vrow >> 4) + (vrow & 3)) * MALL + 8 * vpc;
        const bf16_t* ksrc = KT + (size_t)lane * 8;
        const bf16_t* qsrc = Q + (size_t)lane * 8;
        bf16_t* osrc = O + (size_t)lane * 8;
#define P4_OT(c) (((((size_t)((c) >> 7) * 4 + h) * 16 + slice) * 8 + w) * 512)
        f32x4 Sa[2][2];
        if (s_lo == 0) {
#pragma unroll
            for (int mt = 0; mt < 2; ++mt)
#pragma unroll
                for (int nt = 0; nt < 2; ++nt) Sa[mt][nt] = (f32x4){0.f, 0.f, 0.f, 0.f};
        } else {
#pragma unroll
            for (int mt = 0; mt < 2; ++mt)
#pragma unroll
                for (int nt = 0; nt < 2; ++nt) Sa[mt][nt] = *(const f32x4*)(ssave + ((size_t)(item * 512 + tid) * 4 + mt * 2 + nt) * 4);
        }
        bf16x8 qc[8], kc[2][4]; u32x4 oold; u32x4 vraw;
        {
            const int c0 = p4_col0(s_lo, b, dir);
            const u32x4 v0 = *(const u32x4*)(vsrc + c0);
#pragma unroll
            for (int mt = 0; mt < 2; ++mt)
#pragma unroll
                for (int ks = 0; ks < 4; ++ks) kc[mt][ks] = *(const bf16x8*)(ksrc + (((((size_t)(c0 >> 7) * 4 + h) * 16 + (2 * w + mt)) * 4 + ks) * 512));
            if (s_lo >= 2) {
#pragma unroll
                for (int ks = 0; ks < 8; ++ks) qc[ks] = *(const bf16x8*)(qsrc + ((((size_t)((c0 >> 4) + w) * 4 + h) * 8 + ks) * 512));
                oold = *(const u32x4*)(osrc + P4_OT(c0));
            } else {
#pragma unroll
                for (int ks = 0; ks < 8; ++ks) qc[ks] = (bf16x8){0, 0, 0, 0, 0, 0, 0, 0};
                oold = (u32x4){0u, 0u, 0u, 0u};
            }
            vraw = (s_lo + 1 < s_hi) ? *(const u32x4*)(vsrc + p4_col0(s_lo + 1, b, dir)) : v0;
            LDS_BARRIER();
            const int buf = s_lo & 1;
#pragma unroll
            for (int mt = 0; mt < 2; ++mt)
#pragma unroll
                for (int nt = 0; nt < 2; ++nt) *(LAS u32x2*)(Sb + buf * 8448 + (16 * nt + fr) * 264 + 32 * w + 16 * mt + 4 * fq) = pk4(Sa[mt][nt]);
            u32x4 vs; vs.x = cvt_pk_bf16(bf_lo(v0.x) * zv[0], bf_hi(v0.x) * zv[1]); vs.y = cvt_pk_bf16(bf_lo(v0.y) * zv[2], bf_hi(v0.y) * zv[3]);
            vs.z = cvt_pk_bf16(bf_lo(v0.z) * zv[4], bf_hi(v0.z) * zv[5]); vs.w = cvt_pk_bf16(bf_lo(v0.w) * zv[6], bf_hi(v0.w) * zv[7]);
            *(LAS u32x4*)(Vz + buf * 4352 + vrow * 136 + 8 * vpc) = vs;
            LDS_BARRIER();
        }
        for (int s = s_lo; s < s_hi; ++s) {
            const int buf = s & 1; const bool lat = s >= 2, has1 = s + 1 < s_hi, lat1 = has1 && (s + 1 >= 2);
            const int c0 = p4_col0(s, b, dir), c1 = has1 ? p4_col0(s + 1, b, dir) : c0;
            f32x4 oa[2] = {(f32x4){0.f, 0.f, 0.f, 0.f}, (f32x4){0.f, 0.f, 0.f, 0.f}};
            if (lat) {
#pragma unroll
                for (int ks = 0; ks < 8; ++ks)
#pragma unroll
                    for (int nt = 0; nt < 2; ++nt) { const bf16x8 sf = *(const LAS bf16x8*)(Sb + buf * 8448 + (16 * nt + fr) * 264 + 32 * ks + 8 * fq); oa[nt] = MFMA16(sf, qc[ks], oa[nt]); }
            }
            bf16x8 qn[8];
            if (lat1) {
#pragma unroll
                for (int ks = 0; ks < 8; ++ks) qn[ks] = *(const bf16x8*)(qsrc + ((((size_t)((c1 >> 4) + w) * 4 + h) * 8 + ks) * 512));
            } else {
#pragma unroll
                for (int ks = 0; ks < 8; ++ks) qn[ks] = qc[ks];
            }
            f32x4 U[2][2];
#pragma unroll
            for (int mt = 0; mt < 2; ++mt)
#pragma unroll
                for (int nt = 0; nt < 2; ++nt) U[mt][nt] = (f32x4){0.f, 0.f, 0.f, 0.f};
#pragma unroll
            for (int ks = 0; ks < 4; ++ks) {
                bf16x8 vf[2];
#pragma unroll
                for (int nt = 0; nt < 2; ++nt) vf[nt] = *(const LAS bf16x8*)(Vz + buf * 4352 + (16 * nt + fr) * 136 + 32 * ks + 8 * fq);
#pragma unroll
                for (int mt = 0; mt < 2; ++mt)
#pragma unroll
                    for (int nt = 0; nt < 2; ++nt) U[mt][nt] = MFMA16(kc[mt][ks], vf[nt], U[mt][nt]);
            }
            bf16x8 kn[2][4];
#pragma unroll
            for (int mt = 0; mt < 2; ++mt)
#pragma unroll
                for (int ks = 0; ks < 4; ++ks) kn[mt][ks] = has1 ? *(const bf16x8*)(ksrc + (((((size_t)(c1 >> 7) * 4 + h) * 16 + (2 * w + mt)) * 4 + ks) * 512)) : kc[mt][ks];
#pragma unroll
            for (int mt = 0; mt < 2; ++mt)
#pragma unroll
                for (int nt = 0; nt < 2; ++nt) { Sa[mt][nt] = Sa[mt][nt] * dec128 + U[mt][nt];
                    *(LAS u32x2*)(Sb + (buf ^ 1) * 8448 + (16 * nt + fr) * 264 + 32 * w + 16 * mt + 4 * fq) = pk4(Sa[mt][nt]); }
            if (has1) {
                u32x4 vs; vs.x = cvt_pk_bf16(bf_lo(vraw.x) * zv[0], bf_hi(vraw.x) * zv[1]); vs.y = cvt_pk_bf16(bf_lo(vraw.y) * zv[2], bf_hi(vraw.y) * zv[3]);
                vs.z = cvt_pk_bf16(bf_lo(vraw.z) * zv[4], bf_hi(vraw.z) * zv[5]); vs.w = cvt_pk_bf16(bf_lo(vraw.w) * zv[6], bf_hi(vraw.w) * zv[7]);
                *(LAS u32x4*)(Vz + (buf ^ 1) * 4352 + vrow * 136 + 8 * vpc) = vs;
            }
            if (s + 2 < s_hi) vraw = *(const u32x4*)(vsrc + p4_col0(s + 2, b, dir));
            if (lat) {
                float sq = 0.f;
                const u32x2 o0 = pk4(unpk4((u32x2){oold.x, oold.y}) + oa[0] * xi), o1 = pk4(unpk4((u32x2){oold.z, oold.w}) + oa[1] * xi);
                { u32x4 ov; ov.x = o0.x; ov.y = o0.y; ov.z = o1.x; ov.w = o1.y; *(u32x4*)(osrc + P4_OT(c0)) = ov; }
                { const f32x4 f0 = unpk4(o0), f1 = unpk4(o1); sq = ((f0[0] * f0[0] + f0[1] * f0[1]) + (f0[2] * f0[2] + f0[3] * f0[3])) + ((f1[0] * f1[0] + f1[1] * f1[1]) + (f1[2] * f1[2] + f1[3] * f1[3])); }
                if (s_lo != 0) {
                    sq += __shfl_xor(sq, 16); sq += __shfl_xor(sq, 32);
                    if (fq == 0) ssq[((size_t)(c0 + irow) * 4 + h) * 16 + slice] = sq;
                }
            }
            if (lat1) oold = *(const u32x4*)(osrc + P4_OT(c1));
            LDS_BARRIER();
#pragma unroll
            for (int ks = 0; ks < 8; ++ks) qc[ks] = qn[ks];
#pragma unroll
            for (int mt = 0; mt < 2; ++mt)
#pragma unroll
                for (int ks = 0; ks < 4; ++ks) kc[mt][ks] = kn[mt][ks];
        }
#pragma unroll
        for (int mt = 0; mt < 2; ++mt)
#pragma unroll
            for (int nt = 0; nt < 2; ++nt) *(f32x4*)(ssave + ((size_t)(item * 512 + tid) * 4 + mt * 2 + nt) * 4) = Sa[mt][nt];
    }
}

__device__ __forceinline__ void phase5(const Params& p, int blk, int G) {
    const int lane = threadIdx.x & 63; bf16_t* O = (bf16_t*)p.out;
    for (int r = blk * 8 + (threadIdx.x >> 6); r < MTOK * 4; r += G * 8) {
        u32x4* pp = (u32x4*)(O + (size_t)r * 512 + lane * 8); const u32x4 v = *pp;
        float f[8] = {bf_lo(v.x), bf_hi(v.x), bf_lo(v.y), bf_hi(v.y), bf_lo(v.z), bf_hi(v.z), bf_lo(v.w), bf_hi(v.w)};
        float ss = 0.f;
#pragma unroll
        for (int e = 0; e < 8; ++e) ss += f[e] * f[e];
        const float rs = rsqrtf(wave_sum(ss) * (1.0f / 512.0f) + EPS);
        u32x4 o; o.x = cvt_pk_bf16(f[0] * rs, f[1] * rs); o.y = cvt_pk_bf16(f[2] * rs, f[3] * rs); o.z = cvt_pk_bf16(f[4] * rs, f[5] * rs); o.w = cvt_pk_bf16(f[6] * rs, f[7] * rs);
        *pp = o;
    }
}

__device__ __forceinline__ void phase10(const Params& p, int blk, int G) {
    const int lane = threadIdx.x & 63; const float* mod = (const float*)(p.ws + OFF_SMALL + SM_MOD);
    const bf16_t* Y = (const bf16_t*)(p.ws + OFF_Y); bf16_t* H2 = (bf16_t*)(p.ws + OFF_H);
    const int gw = blk * 8 + (threadIdx.x >> 6), NGW = G * 8;
    u32x2 yr[4], yrn[4]; f32x4 xv[4], xvn[4];
    if (gw < MTOK) {
#pragma unroll
        for (int j = 0; j < 4; ++j) { yr[j] = __builtin_nontemporal_load((const u32x2*)(Y + (size_t)gw * 1024 + 4 * lane + 256 * j)); xv[j] = __builtin_nontemporal_load((const f32x4*)(p.in[0] + (size_t)gw * 1024 + 4 * lane + 256 * j)); } }
    for (int row = gw; row < MTOK; row += NGW) {
        const int nrow = row + NGW;
        if (nrow < MTOK) {
#pragma unroll
            for (int j = 0; j < 4; ++j) { yrn[j] = __builtin_nontemporal_load((const u32x2*)(Y + (size_t)nrow * 1024 + 4 * lane + 256 * j)); xvn[j] = __builtin_nontemporal_load((const f32x4*)(p.in[0] + (size_t)nrow * 1024 + 4 * lane + 256 * j)); } }
        const int b = row >> 13; const float* md = mod + b * 6144;
        f32x4 y[4], x1[4]; float ss = 0.f;
#pragma unroll
        for (int j = 0; j < 4; ++j) { y[j] = unpk4(yr[j]); ss += (y[j][0] * y[j][0] + y[j][1] * y[j][1]) + (y[j][2] * y[j][2] + y[j][3] * y[j][3]); }
        const float rs = rsqrtf(wave_sum(ss) * (1.0f / 1024.0f) + EPS); float s2 = 0.f;
#pragma unroll
        for (int j = 0; j < 4; ++j) { const int c = 4 * lane + 256 * j; const f32x4 g = *(const f32x4*)(p.in[7] + c), gt = *(const f32x4*)(md + 2048 + c);
            x1[j] = xv[j] + gt * ((y[j] * rs) * g); *(f32x4*)(p.out + (size_t)row * 1024 + c) = x1[j];
            s2 += (x1[j][0] * x1[j][0] + x1[j][1] * x1[j][1]) + (x1[j][2] * x1[j][2] + x1[j][3] * x1[j][3]); }
        const float rs2 = rsqrtf(wave_sum(s2) * (1.0f / 1024.0f) + EPS);
        const int t = row & (SEQ - 1), gr = t >> 6, gc = t & 63; const int mu = 256 * (b * 32 + (gc >> 1)) + 128 * (gr >> 6) + 64 * (gc & 1) + (gr & 63);
#pragma unroll
        for (int j = 0; j < 4; ++j) { const int c = 4 * lane + 256 * j; const f32x4 g = *(const f32x4*)(p.in[16] + c), s1 = *(const f32x4*)(md + 4096 + c), s0 = *(const f32x4*)(md + 3072 + c);
            const f32x4 r = (x1[j] * rs2) * g * (s1 + 1.0f) + s0; *(u32x2*)(H2 + (size_t)mu * 1024 + c) = pk4(r); }
#pragma unroll
        for (int j = 0; j < 4; ++j) { yr[j] = yrn[j]; xv[j] = xvn[j]; }
    }
}
__device__ __forceinline__ void phase13(const Params& p, int blk, int G) {
    const int lane = threadIdx.x & 63; const float* mod = (const float*)(p.ws + OFF_SMALL + SM_MOD); const bf16_t* F = (const bf16_t*)(p.ws + OFF_F);
    const int gw = blk * 8 + (threadIdx.x >> 6), NGW = G * 8;
    u32x2 fr_[4], frn[4]; f32x4 ov[4], ovn[4];
    if (gw < MTOK) {
#pragma unroll
        for (int j = 0; j < 4; ++j) { fr_[j] = __builtin_nontemporal_load((const u32x2*)(F + (size_t)gw * 1024 + 4 * lane + 256 * j)); ov[j] = __builtin_nontemporal_load((const f32x4*)(p.out + (size_t)gw * 1024 + 4 * lane + 256 * j)); } }
    for (int row = gw; row < MTOK; row += NGW) {
        const int nrow = row + NGW;
        if (nrow < MTOK) {
#pragma unroll
            for (int j = 0; j < 4; ++j) { frn[j] = __builtin_nontemporal_load((const u32x2*)(F + (size_t)nrow * 1024 + 4 * lane + 256 * j)); ovn[j] = __builtin_nontemporal_load((const f32x4*)(p.out + (size_t)nrow * 1024 + 4 * lane + 256 * j)); } }
        const int b = row >> 13; const float* md = mod + b * 6144;
        f32x4 f[4]; float ss = 0.f;
#pragma unroll
        for (int j = 0; j < 4; ++j) { f[j] = unpk4(fr_[j]); ss += (f[j][0] * f[j][0] + f[j][1] * f[j][1]) + (f[j][2] * f[j][2] + f[j][3] * f[j][3]); }
        const float rs = rsqrtf(wave_sum(ss) * (1.0f / 1024.0f) + EPS);
#pragma unroll
        for (int j = 0; j < 4; ++j) { const int c = 4 * lane + 256 * j; const f32x4 g = *(const f32x4*)(p.in[17] + c), gt = *(const f32x4*)(md + 5120 + c);
            __builtin_nontemporal_store(ov[j] + gt * ((f[j] * rs) * g), (f32x4*)(p.out + (size_t)row * 1024 + c)); }
#pragma unroll
        for (int j = 0; j < 4; ++j) { fr_[j] = frn[j]; ov[j] = ovn[j]; }
    }
}

constexpr int NPHASE = 15;
template <bool COOP>
__global__ void __launch_bounds__(512, 2) k_main(Params p, int ph_lo, int ph_hi) {
    extern __shared__ __attribute__((aligned(16))) unsigned char shm[];
    LAS unsigned char* lds = (LAS unsigned char*)shm;
    const int blk = blockIdx.x, G = gridDim.x;
    unsigned char* ws = p.ws;
    XcdBarrier xb{};
    if constexpr (COOP) {
        volatile LAS unsigned* st = (volatile LAS unsigned*)(lds + LDS_ST_OFF);
        if (threadIdx.x == 0) { st[0] = 0u; st[1] = 0u; st[2] = 0u; st[3] = 0u; }
        __syncthreads();
        xb = xcd_barrier_post((unsigned*)(ws + OFF_SMALL + SM_BAR), st);
    }
    if constexpr (COOP) { if (ph_hi < 0) cg::this_grid().sync(); }
#define RUNPH(ph, SYNC, ...) if (ph_lo <= (ph) && (ph) < ph_hi) { if constexpr (COOP) { if ((ph) > ph_lo) { if (SYNC == 1) cg::this_grid().sync(); else if (SYNC == 2) xcd_barrier(xb); } } __VA_ARGS__ }
    RUNPH(0, 0, phase0(p, lds, blk, G);)
    RUNPH(1, 2, phase1(p, blk, G);)
    RUNPH(2, 2, { SchedP2 S{G, blk, (const char*)(ws + OFF_H), (const char*)(ws + OFF_WT_IN), (size_t)256 * 1024 * 2};
               EpiP2 E{(bf16_t*)p.out, (bf16_t*)p.out + (size_t)MTOK * 1024, (bf16_t*)(ws + OFF_KT), (bf16_t*)(ws + OFF_VT), (const float*)(ws + OFF_SMALL + SM_COSA), (const float*)(ws + OFF_SMALL + SM_SINA),
                       (const float*)(ws + OFF_SMALL + SM_COSB), (const float*)(ws + OFF_SMALL + SM_SINB)};
               pg8::gemm_phase(lds, 1024, S, E); })
    RUNPH(3, 2, phase3(p, lds, blk, G);)
    RUNPH(4, 2, phase4(p, lds, blk, G, 0, 34);)
    RUNPH(5, 2, phase4(p, lds, blk, G, 34, 66);)
    RUNPH(7, 2, { pg8::Sched1 S{64, 28, G, blk, (const char*)(ws + OFF_H), (const char*)(ws + OFF_WT_IN) + (size_t)R_G * 2048, (size_t)256 * 1024 * 2};
               EpiP6 E{(bf16_t*)(ws + OFF_O), (bf16_t*)(ws + OFF_ARET), (bf16_t*)p.out, (bf16_t*)p.out + (size_t)MTOK * 1024, (bf16_t*)(ws + OFF_GB), p.in[9], p.in[10], (const float*)(ws + OFF_SSQP)};
               pg8::gemm_phase(lds, 1024, S, E); })
    RUNPH(8, 2, { pg8::Sched1 S{64, 4, G, blk, (const char*)(ws + OFF_ARET), (const char*)(ws + OFF_WT_RO), (size_t)256 * 2048 * 2};
               EpiMix<1> E{(bf16_t*)(ws + OFF_T), nullptr, (const bf16_t*)(ws + OFF_GB)}; pg8::gemm_phase(lds, 2048, S, E); })
    if constexpr (COOP) { if (ph_lo <= 9 && 9 < ph_hi && 9 > ph_lo) {
        asm volatile("s_waitcnt vmcnt(0)" ::: "memory"); __syncthreads();
        if (threadIdx.x == 0) { __builtin_amdgcn_fence(__ATOMIC_ACQUIRE, "agent"); asm volatile("s_waitcnt vmcnt(0)" ::: "memory"); }
        __syncthreads(); } }
    RUNPH(9, 0, { pg8::Sched1 S{64, 4, G, blk, (const char*)p.out, (const char*)(ws + OFF_WT_CO), (size_t)256 * 1024 * 2};
               EpiMix<2> E{(bf16_t*)(ws + OFF_MERGED), (const bf16_t*)(ws + OFF_T), (const bf16_t*)p.out + (size_t)MTOK * 1024}; pg8::gemm_phase(lds, 1024, S, E); })
    RUNPH(10, 2, { pg8::Sched1 S{64, 4, G, blk, (const char*)(ws + OFF_MERGED), (const char*)(ws + OFF_WT_O), (size_t)256 * 1024 * 2};
                EpiMix<0> E{(bf16_t*)(ws + OFF_Y), nullptr, nullptr}; pg8::gemm_phase(lds, 1024, S, E); })
    RUNPH(11, 2, phase10(p, blk, G);)
    RUNPH(12, 2, { pg8::Sched1 S{64, 22, G, blk, (const char*)(ws + OFF_H), (const char*)(ws + OFF_WT_UP), (size_t)256 * 1024 * 2};
                EpiP11 E{(bf16_t*)(ws + OFF_AFFN), p.in[19], p.in[20]}; pg8::gemm_phase(lds, 1024, S, E); })
    RUNPH(13, 2, { pg8::Sched1 S{64, 4, G, blk, (const char*)(ws + OFF_AFFN), (const char*)(ws + OFF_WT_DN), (size_t)256 * DFF * 2};
                EpiP12 E{(bf16_t*)(ws + OFF_F)}; pg8::gemm_phase(lds, DFF, S, E); })
    RUNPH(14, 2, phase13(p, blk, G);)
#undef RUNPH
}

extern "C" void kernel_launch(void* const* d_in, const int* in_sizes, int n_in, void* d_out, int out_size, void* d_ws, size_t ws_size, hipStream_t stream) {
    static int grid = 0;
    if (grid == 0) {
        if (n_in != 22 || out_size != MTOK * D || ws_size < WS_END) { fprintf(stderr, "kernel_launch: unexpected shapes (n_in %d out %d ws %zu)\n", n_in, out_size, ws_size); grid = -1; return; }
        int dev = 0, cus = 0, per_cu = 0;
        (void)hipGetDevice(&dev); (void)hipDeviceGetAttribute(&cus, hipDeviceAttributeMultiprocessorCount, dev);
        (void)hipFuncSetAttribute((const void*)k_main<true>, hipFuncAttributeMaxDynamicSharedMemorySize, LDS_BYTES);
        (void)hipFuncSetAttribute((const void*)k_main<false>, hipFuncAttributeMaxDynamicSharedMemorySize, LDS_BYTES);
        if (hipOccupancyMaxActiveBlocksPerMultiprocessor(&per_cu, (const void*)k_main<true>, 512, LDS_BYTES) != hipSuccess || per_cu < 1) { fprintf(stderr, "kernel_launch: occupancy query says %d\n", per_cu); per_cu = 1; }
        (void)hipGetLastError();
        grid = cus * 1;
        if (grid > 256) grid = 256;
    }
    if (grid < 0) return;
    Params p{};
    for (int i = 0; i < 22; ++i) p.in[i] = (const float*)d_in[i];
    p.out = (float*)d_out; p.ws = (unsigned char*)d_ws;
#if N_LAUNCH_MODE == 0
    (void)hipMemsetAsync((unsigned char*)d_ws + OFF_SMALL + SM_BAR, 0, XCD_BAR_WORDS * 4, stream);
    int lo = 0, hi = NPHASE; void* args[] = {&p, &lo, &hi};
    hipError_t e = hipLaunchCooperativeKernel((const void*)k_main<true>, dim3(grid), dim3(512), args, LDS_BYTES, stream);
    if (e != hipSuccess) fprintf(stderr, "cooperative launch failed: %s (grid %d)\n", hipGetErrorString(e), grid);
#else
    for (int ph = 0; ph < NPHASE; ++ph) hipLaunchKernelGGL(k_main<false>, dim3(grid), dim3(512), LDS_BYTES, stream, p, ph, ph + 1);
#endif
}
```
